# Optimizing an MI355X kernel written in HIP

```python
import math
import jax, jax.numpy as jnp
from jax import lax
import numpy as np

D_MODEL = 1024
BATCH = 2
SEQ = 8192
DEPTH = 2
DEC_BATCH = 16
DEC_SEQ = 32
PAST_LEN = 2048

CHUNK = 64
N_META = 16
D_LRU = 1024
LRU_HEADS = 8
LRU_BLOCK = D_LRU // LRU_HEADS
LRU_C = 8.0
CONV_W = 4
D_POOL = 1024
POOL_WINDOWS = (2, 4, 8, 16)
POOL_GROUPS = len(POOL_WINDOWS)
POOL_GROUP = D_POOL // POOL_GROUPS
POOL_MAX = 16
D_FF = ((8 * D_MODEL // 3 + 255) // 256) * 256
D_IN = D_LRU + D_POOL + 2 * D_MODEL
EPS = 1e-6

kernel_name = 'hawk_pool_hybrid_stream_step'


def _rmsnorm(x, g):
    x32 = x.astype(jnp.float32)
    y = x32 * lax.rsqrt(jnp.mean(x32 * x32, axis=-1, keepdims=True) + EPS)
    return (y * g.astype(jnp.float32)).astype(x.dtype)


def _causal_conv(x, prev, w, b):
    T = x.shape[1]
    xe = jnp.concatenate([prev, x], axis=1)
    y = b + w[0] * xe[:, 0:T]
    for k in range(1, CONV_W):
        y = y + w[k] * xe[:, k:k + T]
    return y, xe[:, -(CONV_W - 1):]


def _lin_combine(left, right):
    a_l, b_l = left
    a_r, b_r = right
    return a_l * a_r, a_r * b_l + b_r


def _rg_lru(x, pos, h0, w_r, b_r, w_i, b_i, lam):
    B, T, C = x.shape
    xh = x.reshape(B, T, LRU_HEADS, LRU_BLOCK)
    r = jax.nn.sigmoid(jnp.einsum('bthi,hij->bthj', xh, w_r).reshape(B, T, C) + b_r)
    i = jax.nn.sigmoid(jnp.einsum('bthi,hij->bthj', xh, w_i).reshape(B, T, C) + b_i)
    log_a = LRU_C * r.astype(jnp.float32) * jax.nn.log_sigmoid(lam.astype(jnp.float32))
    a = jnp.exp(log_a)
    mult = jnp.sqrt(-jnp.expm1(2.0 * log_a))
    mult = jnp.where((pos == 0)[None, :, None], 1.0, mult)
    bt = mult * (i * x).astype(jnp.float32)
    bt = bt.at[:, 0].add(a[:, 0] * h0.astype(jnp.float32))
    _, h = lax.associative_scan(_lin_combine, (a, bt), axis=1)
    return h.astype(x.dtype), h[:, -1].astype(x.dtype)


def _pool_mix(x, pos, prev, w_g, scale):
    B, T, C = x.shape
    P = POOL_MAX - 1
    xe_raw = jnp.concatenate([prev, x], axis=1)
    xe = xe_raw.astype(jnp.float32)
    cs = jnp.cumsum(xe, axis=1)
    cs = jnp.concatenate([jnp.zeros_like(cs[:, :1]), cs], axis=1)
    outs = []
    for g, w in enumerate(POOL_WINDOWS):
        lo, hi = g * POOL_GROUP, (g + 1) * POOL_GROUP
        s = cs[:, P + 1:P + 1 + T, lo:hi] - cs[:, P + 1 - w:P + 1 - w + T, lo:hi]
        cnt = jnp.minimum(w, pos + 1).astype(jnp.float32)[None, :, None]
        outs.append(s / cnt)
    pooled = jnp.concatenate(outs, axis=-1)
    d = (pooled - xe[:, P:]).astype(x.dtype).reshape(B, T, POOL_GROUPS, POOL_GROUP)
    y = jnp.einsum('btgi,gij->btgj', d, w_g).reshape(B, T, C) * scale
    return y, xe_raw[:, -P:]


def _mixer(xn, pos, conv_prev, h0, pool_prev, w_in, conv_w, conv_b, w_r, b_r, w_i, b_i,
           lam, pool_w, pool_scale, w_br_a, w_br_b, w_out):
    proj = xn @ w_in
    x_a, x_b, g_a, g_b = jnp.split(proj, [D_LRU, D_LRU + D_POOL, D_LRU + D_POOL + D_MODEL], axis=-1)
    c_a, conv_state = _causal_conv(x_a, conv_prev, conv_w, conv_b)
    y_a, h_last = _rg_lru(c_a, pos, h0, w_r, b_r, w_i, b_i, lam)
    y_b, pool_state = _pool_mix(x_b, pos, pool_prev, pool_w, pool_scale)
    merged = jax.nn.sigmoid(g_a) * (y_a @ w_br_a) + jax.nn.sigmoid(g_b) * (y_b @ w_br_b)
    return merged @ w_out, conv_state, h_last, pool_state


def _swiglu(xn, w_gu, w_down):
    gu = xn @ w_gu
    g, u = jnp.split(gu, [D_FF], axis=-1)
    return (jax.nn.silu(g) * u) @ w_down


def setup_inputs(seed: int = 0) -> dict:
    key = jax.random.key(seed)
    ks = jax.random.split(key, 26)
    f32 = jnp.float32
    nrm = lambda k, s, sc: jax.random.normal(k, s, f32) * sc
    u = jax.random.uniform(ks[10], (DEPTH, D_LRU), f32, 0.9, 0.999)
    a_base = u ** (1.0 / LRU_C)
    lam = jnp.log(a_base) - jnp.log1p(-a_base)
    return {
        'x_prompt': nrm(ks[0], (BATCH, SEQ, D_MODEL), 1.0),
        'x_sample': nrm(ks[1], (DEC_BATCH, DEC_SEQ, D_MODEL), 1.0),
        'state_conv': nrm(ks[2], (DEPTH, DEC_BATCH, CONV_W - 1, D_LRU), 1.0),
        'state_lru': nrm(ks[3], (DEPTH, DEC_BATCH, D_LRU), 0.5),
        'state_pool': nrm(ks[4], (DEPTH, DEC_BATCH, POOL_MAX - 1, D_POOL), 1.0),
        'meta_tokens': nrm(ks[5], (N_META, D_MODEL), 1.0),
        'norm1_g': 1.0 + nrm(ks[6], (DEPTH, D_MODEL), 0.05),
        'w_in': nrm(ks[7], (DEPTH, D_MODEL, D_IN), D_MODEL ** -0.5),
        'conv_w': nrm(ks[8], (DEPTH, CONV_W, D_LRU), CONV_W ** -0.5),
        'conv_b': nrm(ks[9], (DEPTH, D_LRU), 0.01),
        'lam': lam,
        'w_r': nrm(ks[11], (DEPTH, LRU_HEADS, LRU_BLOCK, LRU_BLOCK), LRU_BLOCK ** -0.5),
        'b_r': nrm(ks[12], (DEPTH, D_LRU), 0.01),
        'w_i': nrm(ks[13], (DEPTH, LRU_HEADS, LRU_BLOCK, LRU_BLOCK), LRU_BLOCK ** -0.5),
        'b_i': nrm(ks[14], (DEPTH, D_LRU), 0.01),
        'pool_w': nrm(ks[15], (DEPTH, POOL_GROUPS, POOL_GROUP, POOL_GROUP), POOL_GROUP ** -0.5),
        'pool_scale': 1.0 + nrm(ks[16], (DEPTH, D_POOL), 0.05),
        'w_br_a': nrm(ks[17], (DEPTH, D_LRU, D_MODEL), D_LRU ** -0.5),
        'w_br_b': nrm(ks[18], (DEPTH, D_POOL, D_MODEL), D_POOL ** -0.5),
        'w_out': nrm(ks[19], (DEPTH, D_MODEL, D_MODEL), D_MODEL ** -0.5),
        'norm2_g': 1.0 + nrm(ks[20], (DEPTH, D_MODEL), 0.05),
        'w_gu': nrm(ks[21], (DEPTH, D_MODEL, 2 * D_FF), D_MODEL ** -0.5),
        'w_down': nrm(ks[22], (DEPTH, D_FF, D_MODEL), D_FF ** -0.5),
        'final_g': 1.0 + nrm(ks[23], (D_MODEL,), 0.05),
    }


def reference(x_prompt, x_sample, state_conv, state_lru, state_pool, meta_tokens,
              norm1_g, w_in, conv_w, conv_b, lam, w_r, b_r, w_i, b_i, pool_w, pool_scale,
              w_br_a, w_br_b, w_out, norm2_g, w_gu, w_down, final_g):
    B = x_prompt.shape[0]
    meta = jnp.broadcast_to(meta_tokens[None].astype(x_prompt.dtype), (B, N_META, D_MODEL))
    xp = jnp.concatenate([meta, x_prompt], axis=1)
    xs = x_sample
    Tp, Ts = xp.shape[1], xs.shape[1]
    pos_p = jnp.arange(Tp, dtype=jnp.int32)
    pos_s = PAST_LEN + jnp.arange(Ts, dtype=jnp.int32)
    zconv = jnp.zeros((B, CONV_W - 1, D_LRU), xp.dtype)
    zh = jnp.zeros((B, D_LRU), xp.dtype)
    zpool = jnp.zeros((B, POOL_MAX - 1, D_POOL), xp.dtype)
    cp_l, hp_l, pp_l, cs_l, hs_l, ps_l = [], [], [], [], [], []
    for l in range(DEPTH):
        lw = (w_in[l], conv_w[l], conv_b[l], w_r[l], b_r[l], w_i[l], b_i[l], lam[l],
              pool_w[l], pool_scale[l], w_br_a[l], w_br_b[l], w_out[l])
        mp, c_p, h_p, p_p = _mixer(_rmsnorm(xp, norm1_g[l]), pos_p, zconv, zh, zpool, *lw)
        ms, c_s, h_s, p_s = _mixer(_rmsnorm(xs, norm1_g[l]), pos_s, state_conv[l], state_lru[l],
                                   state_pool[l], *lw)
        xp = xp + mp
        xs = xs + ms
        xp = xp + _swiglu(_rmsnorm(xp, norm2_g[l]), w_gu[l], w_down[l])
        xs = xs + _swiglu(_rmsnorm(xs, norm2_g[l]), w_gu[l], w_down[l])
        cp_l.append(c_p); hp_l.append(h_p); pp_l.append(p_p)
        cs_l.append(c_s); hs_l.append(h_s); ps_l.append(p_s)
    y_prompt = _rmsnorm(xp, final_g)[:, N_META:]
    y_sample = _rmsnorm(xs, final_g)
    return (y_prompt, y_sample, jnp.stack(cp_l), jnp.stack(hp_l), jnp.stack(pp_l),
            jnp.stack(cs_l), jnp.stack(hs_l), jnp.stack(ps_l))
```

```cpp
#include <hip/hip_runtime.h>
#include <cstdio>
#include <cstdint>

#ifndef MK_PER_PHASE
#define MK_PER_PHASE 1
#endif

#define GAS __attribute__((address_space(1)))
#define LAS __attribute__((address_space(3)))

typedef unsigned short bf16_t;
typedef short bf16x8 __attribute__((ext_vector_type(8)));
typedef float f32x4 __attribute__((ext_vector_type(4)));
typedef float f32x2 __attribute__((ext_vector_type(2)));
typedef unsigned u32x4 __attribute__((ext_vector_type(4)));
typedef unsigned u32x2 __attribute__((ext_vector_type(2)));

constexpr int D = 1024, DFF = 2816, NGU = 2 * DFF, NIN = 4096;
constexpr int SEQ = 8192, DEC_B = 16, DEC_T = 32, DEPTH = 2;
constexpr int ROWS_P = 2 * SEQ;
constexpr int ROWS_S = DEC_B * DEC_T;
constexpr int ROW_M0 = ROWS_P + ROWS_S;
constexpr int MP = 17152, NTILE = 67;
constexpr float EPS = 1e-6f;

constexpr size_t O_YS = (size_t)ROWS_P * D;
constexpr size_t O_CONV_P = O_YS + (size_t)ROWS_S * D;
constexpr size_t O_LRU_P = O_CONV_P + (size_t)DEPTH * 2 * 3 * D;
constexpr size_t O_POOL_P = O_LRU_P + (size_t)DEPTH * 2 * D;
constexpr size_t O_CONV_S = O_POOL_P + (size_t)DEPTH * 2 * 15 * D;
constexpr size_t O_LRU_S = O_CONV_S + (size_t)DEPTH * 16 * 3 * D;
constexpr size_t O_POOL_S = O_LRU_S + (size_t)DEPTH * 16 * D;
constexpr size_t O_END = O_POOL_S + (size_t)DEPTH * 16 * 15 * D;

constexpr size_t MiB = 1u << 20;
constexpr size_t SZ_ACT = (size_t)MP * D * 2;
constexpr size_t WS_CTL = 0, CTL_ZERO_BYTES = 1 * MiB;
constexpr size_t WS_SSQ = 64 * 1024;
constexpr size_t WS_SUM = 1 * MiB;
constexpr size_t WS_HALOA = 2 * MiB;
constexpr size_t WS_XMETA = 3 * MiB;
constexpr size_t WS_W = 4 * MiB;
constexpr size_t W_IN = WS_W, W_GU = W_IN + 8 * MiB, W_DN = W_GU + 11 * MiB, W_BRA = W_DN + 5632 * 1024, W_BRB = W_BRA + 2 * MiB, W_OUT = W_BRB + 2 * MiB, W_POOL = W_OUT + 2 * MiB;
constexpr size_t WS_XBUF = 36 * MiB;
constexpr size_t WS_PA = 70 * MiB, WS_PB = WS_PA + SZ_ACT, WS_PGA = WS_PB + SZ_ACT, WS_PGB = WS_PGA + SZ_ACT;
constexpr size_t WS_YB = WS_PGB + SZ_ACT;
constexpr size_t WS_END = WS_YB + SZ_ACT;
static_assert(W_POOL + 512 * 1024 <= WS_XBUF && WS_XBUF + SZ_ACT <= WS_PA && WS_END <= 256 * MiB, "d_ws map");
static_assert((size_t)MP * DFF * 2 <= 4 * SZ_ACT, "H overlay");
constexpr int CW_TMO = 0, CW_BAR = 4096;

constexpr int RING_BYTES = 131072, LDSCTL_OFF = RING_BYTES, MISC_OFF = LDSCTL_OFF + 320, LDS_BYTES = 147456;
constexpr int NWAVES = 8;

__device__ __forceinline__ unsigned cvt_pk_bf16(float lo, float hi) { unsigned r; asm volatile("v_cvt_pk_bf16_f32 %0, %1, %2" : "=v"(r) : "v"(lo), "v"(hi)); return r; }
__device__ __forceinline__ float bf_lo(unsigned w) { return __uint_as_float(w << 16); }
__device__ __forceinline__ float bf_hi(unsigned w) { return __uint_as_float(w & 0xffff0000u); }
__device__ __forceinline__ float fast_sigmoid(float v) { return __builtin_amdgcn_rcpf(1.0f + __builtin_amdgcn_exp2f(v * -1.44269504089f)); }
__device__ __forceinline__ float wave_sum(float v) {
#pragma unroll
    for (int o = 1; o < 64; o <<= 1) v += __shfl_xor(v, o);
    return v;
}
__device__ __forceinline__ void unpack8(const u32x4 w, float (&o)[8]) {
    o[0] = bf_lo(w.x); o[1] = bf_hi(w.x); o[2] = bf_lo(w.y); o[3] = bf_hi(w.y); o[4] = bf_lo(w.z); o[5] = bf_hi(w.z); o[6] = bf_lo(w.w); o[7] = bf_hi(w.w);
}
__device__ __forceinline__ u32x4 pack8(const float (&v)[8]) {
    u32x4 w; w.x = cvt_pk_bf16(v[0], v[1]); w.y = cvt_pk_bf16(v[2], v[3]); w.z = cvt_pk_bf16(v[4], v[5]); w.w = cvt_pk_bf16(v[6], v[7]); return w;
}
#define LDS_WAIT() asm volatile("s_waitcnt lgkmcnt(0)" ::: "memory")
#define VM_WAIT() asm volatile("s_waitcnt vmcnt(0)" ::: "memory")

namespace pg8 {
constexpr int BM = 256, BK = 64, HALF = 128, HTB = HALF * BK * 2, STAGE_BYTES = 8 * HTB, NXCD = 8, WGM = 8;
__host__ __device__ __forceinline__ int lds_byte(int r, int c) { const int st = (r >> 4) * 2 + (c >> 5), rr = r & 15, cc = c & 31, ob = rr * 64 + cc * 2; return st * 1024 + (ob ^ (((ob >> 9) & 1) << 5)); }
__host__ __device__ __forceinline__ void stage_rc(int b, int& R, int& C) { const int st = b / 1024, sb = b % 1024, swz = sb ^ (((sb >> 9) & 1) << 5); R = (st >> 1) * 16 + swz / 64; C = (st & 1) * 32 + (swz % 64) / 2; }
__host__ __device__ __forceinline__ int perm32(int rho) { const int n = rho >> 4, i = rho & 15; return 8 * (i >> 2) + 4 * n + (i & 3); }

struct Unit { int pm, pn; };
struct Gemm { const bf16_t* A; const bf16_t* Bt; int M, N, K, lda, a_pn_off; };

struct StaticOrder {
    int nM, nN, nwg, G, c;
    __device__ void init(int M, int N, int G_, int c_) { nM = M / BM; nN = N / BM; nwg = nM * nN; G = G_; c = c_; }
    __device__ bool next(int i, Unit& u) const {
        const long L = (long)i * G + c; if (L >= nwg) return false;
        int wgid = (int)L; { const int q = nwg / NXCD, r = nwg % NXCD, xcd = wgid % NXCD, off = wgid / NXCD; wgid = (xcd < r ? xcd * (q + 1) : r * (q + 1) + (xcd - r) * q) + off; }
        const int nig = WGM * nN, gid = wgid / nig, fm = gid * WGM, gsz = (nM - fm) < WGM ? (nM - fm) : WGM;
        u.pm = fm + ((wgid % nig) % gsz); u.pn = (wgid % nig) / gsz; return true;
    }
};

template <class Epi>
__device__ __forceinline__ void gemm_phase(LAS unsigned char* lds, const Gemm g, const StaticOrder& S, const Epi& E) {
    int tid_ = threadIdx.x; asm volatile("" : "+v"(tid_));
    const int tid = tid_, wid = __builtin_amdgcn_readfirstlane(tid >> 6), lane = tid & 63, wr = wid >> 2, wc = wid & 3, fr = lane & 15, fq = lane >> 4;
    const int K = g.K, nt = K / BK, lda = g.lda;
    unsigned voffA[2], voffB[2];
#pragma unroll
    for (int i = 0; i < 2; ++i) { int R, C; stage_rc(tid * 16 + i * 8192, R, C); const int Rb = (R & ~31) + perm32(R & 31);
        voffA[i] = (unsigned)(R * lda + C) * 2u; voffB[i] = (unsigned)(Rb * K + C) * 2u; }
    const size_t kstep = (size_t)(BK * 2);
    const size_t hstepA = (size_t)HALF * lda * 2, tstepA = 2 * hstepA;
    const size_t hstepB = (size_t)HALF * K * 2, tstepB = 2 * hstepB;
    const size_t pnoffA = (size_t)g.a_pn_off * 2;
    const unsigned ldsw = (unsigned)wid * 1024u;
    const int aoff = lds_byte(wr * 64 + fr, fq * 8), boff = lds_byte(wc * 32 + fr, fq * 8);
#define PG8_SA(b, h) (((b) * 2 + (h)) * HTB)
#define PG8_SB(b, h) ((4 + (b) * 2 + (h)) * HTB)
#define PG8_STAGE(bufoff, gbase, voff) do { _Pragma("unroll") for (int _i = 0; _i < 2; ++_i) \
        __builtin_amdgcn_global_load_lds((const unsigned*)((const char*)(gbase) + (voff)[_i]), (LAS unsigned*)(lds + (bufoff) + ldsw + _i * 8192), 16, 0, 0); } while (0)
#define PG8_LDA(dst, b, h) do { _Pragma("unroll") for (int m = 0; m < 4; ++m) _Pragma("unroll") for (int k = 0; k < 2; ++k) dst[m][k] = *(const LAS bf16x8*)(lds + PG8_SA(b, h) + aoff + m * 2048 + k * 1024); } while (0)
#define PG8_LDB(dst, b, h) do { _Pragma("unroll") for (int n = 0; n < 2; ++n) _Pragma("unroll") for (int k = 0; k < 2; ++k) dst[n][k] = *(const LAS bf16x8*)(lds + PG8_SB(b, h) + boff + n * 2048 + k * 1024); } while (0)
#define PG8_MMA(ai, bj, At, Bt) do { __builtin_amdgcn_s_setprio(1); _Pragma("unroll") for (int m = 0; m < 4; ++m) _Pragma("unroll") for (int n = 0; n < 2; ++n) _Pragma("unroll") for (int k = 0; k < 2; ++k) \
        acc[ai][bj][m][n] = __builtin_amdgcn_mfma_f32_16x16x32_bf16(Bt[n][k], At[m][k], acc[ai][bj][m][n], 0, 0, 0); __builtin_amdgcn_s_setprio(0); } while (0)
#define PG8_WAIT_V(n) asm volatile("s_waitcnt vmcnt(" #n ")" ::: "memory")
#define PG8_WAIT_L(n) asm volatile("s_waitcnt lgkmcnt(" #n ")" ::: "memory")
#define PG8_BAR __builtin_amdgcn_s_barrier()
#define PG8_SCHED __builtin_amdgcn_sched_barrier(0)
    Unit cur, nxt; int ui = 0;
    if (!S.next(0, cur)) return;
    f32x4 acc[2][2][4][2];
#pragma unroll
    for (int a = 0; a < 2; ++a)
#pragma unroll
        for (int b = 0; b < 2; ++b)
#pragma unroll
            for (int m = 0; m < 4; ++m)
#pragma unroll
                for (int n = 0; n < 2; ++n) acc[a][b][m][n] = (f32x4){0.f, 0.f, 0.f, 0.f};
    bf16x8 At[4][2], B0[2][2], B1[2][2];
    const char* cA = (const char*)g.A + (size_t)cur.pm * tstepA + (size_t)cur.pn * pnoffA; const char* cB = (const char*)g.Bt + (size_t)cur.pn * tstepB;
    PG8_STAGE(PG8_SB(0, 0), cB, voffB); PG8_STAGE(PG8_SB(0, 1), cB + hstepB, voffB); PG8_STAGE(PG8_SA(0, 0), cA, voffA); PG8_STAGE(PG8_SA(0, 1), cA + hstepA, voffA);
    if (wr == 1) PG8_BAR;
    PG8_WAIT_V(2); PG8_BAR;
    PG8_STAGE(PG8_SB(1, 0), cB + kstep, voffB); PG8_STAGE(PG8_SA(1, 0), cA + kstep, voffA); PG8_STAGE(PG8_SB(1, 1), cB + hstepB + kstep, voffB);
    PG8_WAIT_V(6); PG8_BAR;
    for (;;) {
        const bool has_next = S.next(ui + 1, nxt);
        const char* nA = has_next ? (const char*)g.A + (size_t)nxt.pm * tstepA + (size_t)nxt.pn * pnoffA : cA; const char* nB = has_next ? (const char*)g.Bt + (size_t)nxt.pn * tstepB : cB;
#pragma unroll 1
        for (int t = 0; t < nt; t += 2) {
            const bool last = (t == nt - 2);
            const char* a1 = cA + (size_t)(t + 1) * kstep;
            const char* a2 = last ? nA : cA + (size_t)(t + 2) * kstep; const char* b2 = last ? nB : cB + (size_t)(t + 2) * kstep;
            const char* a3 = a2 + kstep; const char* b3 = b2 + kstep;
            PG8_LDB(B0, 0, 0); PG8_LDB(B1, 0, 1); PG8_SCHED; PG8_LDA(At, 0, 0); PG8_STAGE(PG8_SA(1, 1), a1 + hstepA, voffA);
            PG8_WAIT_V(8); PG8_WAIT_L(0); PG8_BAR; PG8_MMA(0, 0, At, B0); PG8_MMA(0, 1, At, B1); PG8_BAR; PG8_SCHED;
            PG8_LDA(At, 0, 1); PG8_STAGE(PG8_SB(0, 0), b2, voffB); PG8_STAGE(PG8_SB(0, 1), b2 + hstepB, voffB); PG8_STAGE(PG8_SA(0, 0), a2, voffA);
            PG8_WAIT_V(8); PG8_WAIT_L(0); PG8_BAR; PG8_MMA(1, 0, At, B0); PG8_MMA(1, 1, At, B1); PG8_BAR; PG8_SCHED;
            PG8_LDB(B0, 1, 0); PG8_LDB(B1, 1, 1); PG8_SCHED; PG8_LDA(At, 1, 0); PG8_STAGE(PG8_SA(0, 1), a2 + hstepA, voffA);
            PG8_WAIT_V(8); PG8_WAIT_L(0); PG8_BAR; PG8_MMA(0, 0, At, B0); PG8_MMA(0, 1, At, B1); PG8_BAR; PG8_SCHED;
            PG8_LDA(At, 1, 1); PG8_STAGE(PG8_SB(1, 0), b3, voffB); PG8_STAGE(PG8_SB(1, 1), b3 + hstepB, voffB); PG8_STAGE(PG8_SA(1, 0), a3, voffA);
            PG8_WAIT_V(8); PG8_WAIT_L(0); PG8_BAR; PG8_MMA(1, 0, At, B0); PG8_MMA(1, 1, At, B1); PG8_BAR; PG8_SCHED;
        }
        if (wr == 0) PG8_BAR;
        { int fr_e = fr, fq_e = fq; asm volatile("" : "+v"(fr_e), "+v"(fq_e)); E(acc, cur, wr, wc, fr_e, fq_e); }
        if (!has_next) break;
#pragma unroll
        for (int a = 0; a < 2; ++a)
#pragma unroll
            for (int b = 0; b < 2; ++b)
#pragma unroll
                for (int m = 0; m < 4; ++m)
#pragma unroll
                    for (int n = 0; n < 2; ++n) acc[a][b][m][n] = (f32x4){0.f, 0.f, 0.f, 0.f};
        cur = nxt; cA = nA; cB = nB; ++ui;
        if (wr == 1) PG8_BAR;
    }
    PG8_WAIT_V(0);
    PG8_BAR;
#undef PG8_SA
#undef PG8_SB
#undef PG8_STAGE
#undef PG8_LDA
#undef PG8_LDB
#undef PG8_MMA
#undef PG8_WAIT_V
#undef PG8_WAIT_L
#undef PG8_BAR
#undef PG8_SCHED
}
}

#define EPI_ROWS_BEGIN _Pragma("unroll") for (int ai = 0; ai < 2; ++ai) _Pragma("unroll") for (int m = 0; m < 4; ++m) { const int lr = ai * 128 + wr * 64 + m * 16 + fr; const int row = u.pm * 256 + lr; (void)row;
#define EPI_ROWS_END asm volatile("" ::: "memory"); }

struct EpiIn {
    bf16_t* P;
    bf16_t* haloA;
    const float* ssq;
    float* out;
    int layer;
    __device__ __forceinline__ void operator()(const f32x4 (&acc)[2][2][4][2], const pg8::Unit& u, int wr, int wc, int fr, int fq) const {
        const int t = u.pn >> 2;
        bf16_t* base = P + (size_t)t * (SZ_ACT / 2);
        const int lc0 = (u.pn & 3) * 256 + wc * 32 + 8 * fq;
        const bool special = (t < 2);
        EPI_ROWS_BEGIN
            const float rs = __builtin_amdgcn_rsqf(ssq[row] * (1.0f / D) + EPS);
#pragma unroll
            for (int bj = 0; bj < 2; ++bj) {
                float v[8];
#pragma unroll
                for (int n = 0; n < 2; ++n)
#pragma unroll
                    for (int e = 0; e < 4; ++e) { float x = acc[ai][bj][m][n][e] * rs; if (t >= 2) x = fast_sigmoid(x); v[n * 4 + e] = x; }
                const u32x4 w = pack8(v);
                const int lc = lc0 + bj * 128;
                *(u32x4*)(base + (size_t)row * D + lc) = w;
                if (special) {
                    if (t == 0) {
                        if (u.pm < 64) { if ((u.pm & 31) != 31 && lr >= 253) *(u32x4*)(haloA + ((size_t)(u.pm + 1) * 3 + (lr - 253)) * D + lc) = w; }
                        else if (u.pm == 66) { if (lr >= 13 && lr < 16) *(u32x4*)(haloA + ((size_t)0 * 3 + (lr - 13)) * D + lc) = w;
                                               if (lr >= 29 && lr < 32) *(u32x4*)(haloA + ((size_t)32 * 3 + (lr - 29)) * D + lc) = w; }
                        float* o = nullptr;
                        if (u.pm < 64) { if ((u.pm & 31) == 31 && lr >= 253) o = out + O_CONV_P + ((size_t)(layer * 2 + (u.pm >> 5)) * 3 + (lr - 253)) * D + lc; }
                        else if (u.pm < 66) { const int ts = lr & 31; if (ts >= 29) o = out + O_CONV_S + ((size_t)(layer * 16 + 8 * (u.pm - 64) + (lr >> 5)) * 3 + (ts - 29)) * D + lc; }
                        if (o) { *(f32x4*)o = (f32x4){v[0], v[1], v[2], v[3]}; *(f32x4*)(o + 4) = (f32x4){v[4], v[5], v[6], v[7]}; }
                    } else {
                        float* o = nullptr;
                        if (u.pm < 64) { if ((u.pm & 31) == 31 && lr >= 241) o = out + O_POOL_P + ((size_t)(layer * 2 + (u.pm >> 5)) * 15 + (lr - 241)) * D + lc; }
                        else if (u.pm < 66) { const int ts = lr & 31; if (ts >= 17) o = out + O_POOL_S + ((size_t)(layer * 16 + 8 * (u.pm - 64) + (lr >> 5)) * 15 + (ts - 17)) * D + lc; }
                        if (o) { *(f32x4*)o = (f32x4){v[0], v[1], v[2], v[3]}; *(f32x4*)(o + 4) = (f32x4){v[4], v[5], v[6], v[7]}; }
                    }
                }
            }
        EPI_ROWS_END
    }
};

struct EpiStore {
    bf16_t* O; int ldc;
    __device__ __forceinline__ void operator()(const f32x4 (&acc)[2][2][4][2], const pg8::Unit& u, int wr, int wc, int fr, int fq) const {
        const int c0 = u.pn * 256 + wc * 32 + 8 * fq;
        EPI_ROWS_BEGIN
#pragma unroll
            for (int bj = 0; bj < 2; ++bj) {
                float v[8];
#pragma unroll
                for (int n = 0; n < 2; ++n)
#pragma unroll
                    for (int e = 0; e < 4; ++e) v[n * 4 + e] = acc[ai][bj][m][n][e];
                *(u32x4*)(O + (size_t)row * ldc + c0 + bj * 128) = pack8(v);
            }
        EPI_ROWS_END
    }
};

template <bool SECOND> struct EpiGate {
    const bf16_t* gate; const bf16_t* t1; bf16_t* O;
    __device__ __forceinline__ void operator()(const f32x4 (&acc)[2][2][4][2], const pg8::Unit& u, int wr, int wc, int fr, int fq) const {
        const int c0 = u.pn * 256 + wc * 32 + 8 * fq;
        EPI_ROWS_BEGIN
#pragma unroll
            for (int bj = 0; bj < 2; ++bj) {
                const size_t off = (size_t)row * D + c0 + bj * 128;
                float gv[8], v[8]; unpack8(*(const u32x4*)(gate + off), gv);
                if (SECOND) { float tv[8]; unpack8(*(const u32x4*)(t1 + off), tv);
#pragma unroll
                    for (int n = 0; n < 2; ++n)
#pragma unroll
                        for (int e = 0; e < 4; ++e) v[n * 4 + e] = tv[n * 4 + e] + gv[n * 4 + e] * acc[ai][bj][m][n][e];
                } else {
#pragma unroll
                    for (int n = 0; n < 2; ++n)
#pragma unroll
                        for (int e = 0; e < 4; ++e) v[n * 4 + e] = gv[n * 4 + e] * acc[ai][bj][m][n][e];
                }
                *(u32x4*)(O + off) = pack8(v);
            }
        EPI_ROWS_END
    }
};

struct EpiRes {
    float* xmain; float* xmeta; bf16_t* xb; float* ssq_next;
    __device__ __forceinline__ void operator()(const f32x4 (&acc)[2][2][4][2], const pg8::Unit& u, int wr, int wc, int fr, int fq) const {
        const int c0 = u.pn * 256 + wc * 32 + 8 * fq;
        float* xbase = (u.pm < 66) ? xmain + (size_t)u.pm * 256 * D : xmeta;
        EPI_ROWS_BEGIN
            float s = 0.f;
#pragma unroll
            for (int bj = 0; bj < 2; ++bj) {
                float* xp = xbase + (size_t)lr * D + c0 + bj * 128;
                const f32x4 x0 = *(const f32x4*)xp, x1 = *(const f32x4*)(xp + 4);
                float v[8];
#pragma unroll
                for (int e = 0; e < 4; ++e) { v[e] = x0[e] + acc[ai][bj][m][0][e]; v[4 + e] = x1[e] + acc[ai][bj][m][1][e]; }
#pragma unroll
                for (int e = 0; e < 8; ++e) s += v[e] * v[e];
                *(f32x4*)xp = (f32x4){v[0], v[1], v[2], v[3]}; *(f32x4*)(xp + 4) = (f32x4){v[4], v[5], v[6], v[7]};
                *(u32x4*)(xb + (size_t)row * D + c0 + bj * 128) = pack8(v);
            }
            s += __shfl_xor(s, 16); s += __shfl_xor(s, 32);
            if (fq == 0) atomicAdd(ssq_next + row, s);
        EPI_ROWS_END
    }
};

struct EpiGU {
    bf16_t* H; const float* ssq;
    __device__ __forceinline__ void operator()(const f32x4 (&acc)[2][2][4][2], const pg8::Unit& u, int wr, int wc, int fr, int fq) const {
        const int c0 = u.pn * 128 + wc * 32 + 8 * fq;
        EPI_ROWS_BEGIN
            const float rs = __builtin_amdgcn_rsqf(ssq[row] * (1.0f / D) + EPS);
            float v[8];
#pragma unroll
            for (int n = 0; n < 2; ++n)
#pragma unroll
                for (int e = 0; e < 4; ++e) { const float gg = acc[ai][0][m][n][e] * rs, uu = acc[ai][1][m][n][e] * rs; v[n * 4 + e] = gg * fast_sigmoid(gg) * uu; }
            *(u32x4*)(H + (size_t)row * DFF + c0) = pack8(v);
        EPI_ROWS_END
    }
};

#define XB_TMO      128
#define XB_XCNT(j)  (256  + 64 * (j))
#define XB_XSUB(j)  (1280 + 64 * (j))
#define XB_XGEN(j)  (2304 + 64 * (j))
#define XB_TOP      3328
#define XB_TOPGEN   3392
#define XCD_BAR_WORDS 3456
#define XB_SPIN_CAP (1u << 20)
__device__ __forceinline__ unsigned xb_ld(unsigned* p)              { return __hip_atomic_load(p, __ATOMIC_RELAXED, __HIP_MEMORY_SCOPE_AGENT); }
__device__ __forceinline__ unsigned xb_add(unsigned* p, unsigned v) { return __hip_atomic_fetch_add(p, v, __ATOMIC_RELAXED, __HIP_MEMORY_SCOPE_AGENT); }
__device__ __forceinline__ unsigned xb_xcc_id() { return (unsigned)__builtin_amdgcn_s_getreg((3 << 11) | 20) & 0xFu; }
#define XB_SPIN(cond, bar) do { unsigned _sp = 0; while (cond) { __builtin_amdgcn_s_sleep(1); \
    if ((++_sp & 255u) == 0u) { if (xb_ld(&(bar)[XB_TMO])) break; if (_sp > XB_SPIN_CAP) { atomicAdd(&(bar)[XB_TMO], 1u); break; } } } } while (0)
struct XcdBarrier { unsigned* bar; unsigned x; volatile LAS unsigned* st; };
__device__ __forceinline__ XcdBarrier xcd_barrier_post(unsigned* bar, volatile LAS unsigned* st) {
    XcdBarrier b; b.bar = bar; b.x = xb_xcc_id(); b.st = st;
    if (threadIdx.x == 0) (void)xb_add(&bar[XB_XCNT(b.x)], 1u);
    return b;
}
__device__ __forceinline__ void xcd_barrier_complete(unsigned* bar, unsigned x, unsigned& nloc, unsigned& nx) {
    const unsigned G = gridDim.x * gridDim.y * gridDim.z;
    unsigned sum, cnt, mine, sp = 0u;
    for (;;) {
        sum = 0u; cnt = 0u; mine = 0u;
#pragma unroll
        for (unsigned j = 0; j < 16; ++j) { const unsigned c = xb_ld(&bar[XB_XCNT(j)]); sum += c; cnt += (c > 0u) ? 1u : 0u; mine = (j == x) ? c : mine; }
        if (sum == G) break;
        __builtin_amdgcn_s_sleep(1);
        if ((++sp & 255u) == 0u) { if (xb_ld(&bar[XB_TMO])) break; if (sp > XB_SPIN_CAP) { atomicAdd(&bar[XB_TMO], 1u); break; } }
    }
    nloc = mine > 0u ? mine : 1u; nx = cnt > 0u ? cnt : 1u;
}
__device__ __forceinline__ void xcd_barrier(const XcdBarrier& b) {
    asm volatile("s_waitcnt vmcnt(0)" ::: "memory");
    __syncthreads();
    if (threadIdx.x == 0) {
        unsigned* bar = b.bar;
        __builtin_amdgcn_s_waitcnt(0);
        unsigned nloc = b.st[0], nx = b.st[1];
        if (nloc == 0u) { xcd_barrier_complete(bar, b.x, nloc, nx); b.st[0] = nloc; b.st[1] = nx; }
        const unsigned old = xb_add(&bar[XB_XSUB(b.x)], 1u);
        const unsigned gen = old / nloc;
        if (old + 1u == (gen + 1u) * nloc) {
            __builtin_amdgcn_fence(__ATOMIC_RELEASE, "agent");
            asm volatile("s_waitcnt vmcnt(0)" ::: "memory");
            const unsigned og = xb_add(&bar[XB_TOP], 1u);
            const unsigned tg = og / nx;
            if (og + 1u == (tg + 1u) * nx) xb_add(&bar[XB_TOPGEN], 1u);
            else XB_SPIN(xb_ld(&bar[XB_TOPGEN]) == tg, bar);
            __builtin_amdgcn_fence(__ATOMIC_ACQUIRE, "agent");
            xb_add(&bar[XB_XGEN(b.x)], 1u);
            asm volatile("s_waitcnt vmcnt(0)" ::: "memory");
        } else {
            XB_SPIN(xb_ld(&bar[XB_XGEN(b.x)]) == gen, bar);
            __builtin_amdgcn_fence(__ATOMIC_ACQUIRE, "agent");
            asm volatile("s_waitcnt vmcnt(0)" ::: "memory");
        }
    }
    __syncthreads();
}

struct Args { const float* in[24]; float* out; unsigned char* ws; int ph_lo, ph_hi; };
enum { I_XP = 0, I_XS, I_SCONV, I_SLRU, I_SPOOL, I_META, I_N1G, I_WIN, I_CONVW, I_CONVB, I_LAM, I_WR, I_BR, I_WI, I_BI, I_POOLW, I_POOLS, I_WBRA, I_WBRB, I_WOUT, I_N2G, I_WGU, I_WDN, I_FING };

__device__ __forceinline__ void phase_init(const Args& a, int gw, int NGW, int lane) {
    float* xmeta = (float*)(a.ws + WS_XMETA); bf16_t* xb = (bf16_t*)(a.ws + WS_XBUF); float* ssq0 = (float*)(a.ws + WS_SSQ);
    for (int r = gw; r < MP; r += NGW) {
        const float* src; float* dst;
        if (r < ROWS_P) { src = a.in[I_XP] + (size_t)r * D; dst = a.out + (size_t)r * D; }
        else if (r < ROW_M0) { src = a.in[I_XS] + (size_t)(r - ROWS_P) * D; dst = a.out + (size_t)r * D; }
        else if (r < ROW_M0 + 32) { src = a.in[I_META] + (size_t)((r - ROW_M0) & 15) * D; dst = xmeta + (size_t)(r - ROW_M0) * D; }
        else { src = nullptr; dst = xmeta + (size_t)(r - ROW_M0) * D; }
        f32x4 v[4]; float s = 0.f;
#pragma unroll
        for (int j = 0; j < 4; ++j) { v[j] = src ? ((const f32x4*)src)[lane + 64 * j] : (f32x4){0.f, 0.f, 0.f, 0.f}; s += (v[j].x * v[j].x + v[j].y * v[j].y) + (v[j].z * v[j].z + v[j].w * v[j].w); }
        s = wave_sum(s);
#pragma unroll
        for (int j = 0; j < 4; ++j) { ((f32x4*)dst)[lane + 64 * j] = v[j];
            u32x2 w; w.x = cvt_pk_bf16(v[j].x, v[j].y); w.y = cvt_pk_bf16(v[j].z, v[j].w); ((u32x2*)(xb + (size_t)r * D))[lane + 64 * j] = w; }
        if (lane == 0) ssq0[r] = s;
    }
}

__device__ __forceinline__ void tr_item(const float* W, int K, int N, bf16_t* WT, int k0, int n0, int row0, const float* kscale, const float* nscale, LAS float* scr, int lane) {
#pragma unroll 8
    for (int i = 0; i < 32; ++i) { const int kk = 2 * i + (lane >> 5); float v = W[(size_t)(k0 + kk) * N + n0 + (lane & 31)]; if (kscale) v *= kscale[k0 + kk]; if (nscale) v *= nscale[n0 + (lane & 31)]; scr[kk * 33 + (lane & 31)] = v; }
    LDS_WAIT(); asm volatile("" ::: "memory");
    const int c = lane & 7;
#pragma unroll
    for (int j = 0; j < 4; ++j) { const int n = (lane >> 3) + 8 * j; const LAS float* s = scr + (8 * c) * 33 + n;
        u32x4 o; o.x = cvt_pk_bf16(s[0 * 33], s[1 * 33]); o.y = cvt_pk_bf16(s[2 * 33], s[3 * 33]); o.z = cvt_pk_bf16(s[4 * 33], s[5 * 33]); o.w = cvt_pk_bf16(s[6 * 33], s[7 * 33]);
        *(u32x4*)(WT + (size_t)(row0 + n) * K + k0 + 8 * c) = o; }
    LDS_WAIT(); asm volatile("" ::: "memory");
}
__device__ __forceinline__ void phase_weights(const Args& a, int l, LAS unsigned char* lds, int gw, int NGW, int wave, int lane) {
    LAS float* scr = (LAS float*)(lds + wave * 16384);
    constexpr int I_IN = 16 * 128, I_GU = 16 * 176, I_DN = 44 * 32, I_SQ = 16 * 32, I_PL = 4 * 8;
    constexpr int NITEMS = I_IN + I_GU + I_DN + 3 * I_SQ + 4 * I_PL;
    for (int it = gw; it < NITEMS; it += NGW) {
        int r = it;
        if (r < I_IN) { const int kb = r / 128, nb = r % 128; tr_item(a.in[I_WIN] + (size_t)l * D * NIN, D, NIN, (bf16_t*)(a.ws + W_IN), 64 * kb, 32 * nb, 32 * nb, a.in[I_N1G] + l * D, nullptr, scr, lane); continue; } r -= I_IN;
        if (r < I_GU) { const int kb = r / 176, nb = r % 176, n0 = 32 * nb; const int row0 = n0 < DFF ? (n0 >> 7) * 256 + (n0 & 127) : ((n0 - DFF) >> 7) * 256 + 128 + ((n0 - DFF) & 127);
            tr_item(a.in[I_WGU] + (size_t)l * D * NGU, D, NGU, (bf16_t*)(a.ws + W_GU), 64 * kb, n0, row0, a.in[I_N2G] + l * D, nullptr, scr, lane); continue; } r -= I_GU;
        if (r < I_DN) { const int kb = r / 32, nb = r % 32; tr_item(a.in[I_WDN] + (size_t)l * DFF * D, DFF, D, (bf16_t*)(a.ws + W_DN), 64 * kb, 32 * nb, 32 * nb, nullptr, nullptr, scr, lane); continue; } r -= I_DN;
        if (r < 3 * I_SQ) { const int w = r / I_SQ, q = r % I_SQ, kb = q / 32, nb = q % 32;
            const float* src = a.in[w == 0 ? I_WBRA : (w == 1 ? I_WBRB : I_WOUT)] + (size_t)l * D * D; bf16_t* dst = (bf16_t*)(a.ws + (w == 0 ? W_BRA : (w == 1 ? W_BRB : W_OUT)));
            tr_item(src, D, D, dst, 64 * kb, 32 * nb, 32 * nb, nullptr, nullptr, scr, lane); continue; } r -= 3 * I_SQ;
        { const int g = r / I_PL, q = r % I_PL, kb = q / 8, nb = q % 8;
          tr_item(a.in[I_POOLW] + ((size_t)l * 4 + g) * 256 * 256, 256, 256, (bf16_t*)(a.ws + W_POOL), 64 * kb, 32 * nb, g * 256 + 32 * nb, nullptr, a.in[I_POOLS] + l * D + g * 256, scr, lane); }
    }
}

template <int NH>
__device__ __forceinline__ void load8_hist(float (&o)[8], int mode, const bf16_t* P, const bf16_t* halo, const float* st, int pm, int rho, int back, int col0) {
    const bf16_t* p = nullptr; const float* q = nullptr;
    if (mode == 0) {
        const int rr = rho - back;
        if (rr >= 0) p = P + (size_t)(pm * 256 + rr) * D + col0;
        else if (halo) p = halo + (size_t)(pm * NH + NH + rr) * D + col0;
        else if ((pm & 31) != 0) p = P + (size_t)(pm * 256 + rr) * D + col0;
        else p = P + (size_t)(ROW_M0 + (pm >> 5) * 16 + 16 + rr) * D + col0;
    } else if (mode == 1) {
        const int t = rho & 31;
        if (back <= t) p = P + (size_t)(pm * 256 + rho - back) * D + col0;
        else q = st + (size_t)((8 * (pm - 64) + (rho >> 5)) * NH + NH + t - back) * D + col0;
    } else {
        const int k = rho & 15;
        if (rho < 32 && back <= k) p = P + (size_t)(ROW_M0 + rho - back) * D + col0;
    }
    if (p) unpack8(*(const u32x4*)p, o);
    else if (q) { const f32x4 a0 = *(const f32x4*)q, a1 = *(const f32x4*)(q + 4); o[0] = a0.x; o[1] = a0.y; o[2] = a0.z; o[3] = a0.w; o[4] = a1.x; o[5] = a1.y; o[6] = a1.z; o[7] = a1.w; }
    else {
#pragma unroll
        for (int e = 0; e < 8; ++e) o[e] = 0.f;
    }
}

__device__ __forceinline__ void pool_unit(const Args& a, int l, int pm, int wave, int lane_in) {
    int lane = lane_in; asm volatile("" : "+v"(lane));
    const int mode = pm < 64 ? 0 : (pm < 66 ? 1 : 2);
    const bf16_t* PB = (const bf16_t*)(a.ws + WS_PB); bf16_t* Dd = (bf16_t*)(a.ws + WS_XBUF);
    const float* stp = a.in[I_SPOOL] + (size_t)l * 16 * 15 * D;
    const int g = wave & 3, w = 2 << g, col0 = 256 * g + 8 * (lane & 31);
    for (int it = 0; it < 64; ++it) {
        const int rho = (wave >> 2) * 128 + it * 2 + (lane >> 5);
        float s[8], x0[8];
        load8_hist<15>(x0, mode, PB, nullptr, stp, pm, rho, 0, col0);
#pragma unroll
        for (int e = 0; e < 8; ++e) s[e] = x0[e];
        for (int j = 1; j < w; ++j) { float v[8]; load8_hist<15>(v, mode, PB, nullptr, stp, pm, rho, j, col0);
#pragma unroll
            for (int e = 0; e < 8; ++e) s[e] += v[e]; }
        float cnt = (float)w;
        if (mode == 2) { const int k = (rho & 15) + 1; cnt = (float)(k < w ? k : w); }
        const float ic = 1.0f / cnt;
        float d[8];
#pragma unroll
        for (int e = 0; e < 8; ++e) d[e] = (mode == 2 && rho >= 32) ? 0.f : s[e] * ic - x0[e];
        *(u32x4*)(Dd + (size_t)(pm * 256 + rho) * D + col0) = pack8(d);
    }
}

template <bool FINAL>
__device__ __forceinline__ void lru_unit(const Args& a, int l, int pm, int h, LAS unsigned char* lds, int tid_in, int wave, int lane_in) {
    int tid = tid_in, lane = lane_in; asm volatile("" : "+v"(tid), "+v"(lane));
    const int mode = pm < 64 ? 0 : (pm < 66 ? 1 : 2);
    bf16_t* PA = (bf16_t*)(a.ws + WS_PA); const bf16_t* haloA = (const bf16_t*)(a.ws + WS_HALOA);
    const float* stc = a.in[I_SCONV] + (size_t)l * 16 * 3 * D;
    float* sumA = (float*)(a.ws + WS_SUM); float* sumH = sumA + 68 * D;
    const int fr = lane & 15, fq = lane >> 4;
    {
        const int c8 = tid & 15, col0 = h * 128 + 8 * c8;
        float cw[4][8], cb[8];
#pragma unroll
        for (int k = 0; k < 4; ++k) { const float* p = a.in[I_CONVW] + ((size_t)l * 4 + k) * D + col0; const f32x4 a0 = *(const f32x4*)p, a1 = *(const f32x4*)(p + 4);
            cw[k][0] = a0.x; cw[k][1] = a0.y; cw[k][2] = a0.z; cw[k][3] = a0.w; cw[k][4] = a1.x; cw[k][5] = a1.y; cw[k][6] = a1.z; cw[k][7] = a1.w; }
        { const float* p = a.in[I_CONVB] + (size_t)l * D + col0; const f32x4 a0 = *(const f32x4*)p, a1 = *(const f32x4*)(p + 4);
            cb[0] = a0.x; cb[1] = a0.y; cb[2] = a0.z; cb[3] = a0.w; cb[4] = a1.x; cb[5] = a1.y; cb[6] = a1.z; cb[7] = a1.w; }
        for (int it = 0; it < 8; ++it) {
            const int rho = (tid >> 4) + 32 * it;
            float y[8];
#pragma unroll
            for (int e = 0; e < 8; ++e) y[e] = cb[e];
#pragma unroll
            for (int k = 0; k < 4; ++k) { float v[8]; load8_hist<3>(v, mode, PA, haloA, stc, pm, rho, 3 - k, col0);
#pragma unroll
                for (int e = 0; e < 8; ++e) y[e] += cw[k][e] * v[e]; }
            const int swz = (rho & 3) | (((rho >> 6) & 3) << 2);
            *(LAS u32x4*)(lds + rho * 256 + 16 * (c8 ^ swz)) = pack8(y);
        }
    }
    const int chl = 16 * wave + fr, ch = h * 128 + chl;
    bf16x8 Br[4], Bi[4];
    {
        const float* wr_ = a.in[I_WR] + ((size_t)(l * 8 + h) * 128) * 128 + chl; const float* wi_ = a.in[I_WI] + ((size_t)(l * 8 + h) * 128) * 128 + chl;
#pragma unroll
        for (int ks = 0; ks < 4; ++ks) { float tr[8], ti[8];
#pragma unroll
            for (int j = 0; j < 8; ++j) { const int k = 32 * ks + 8 * fq + j; tr[j] = wr_[(size_t)k * 128]; ti[j] = wi_[(size_t)k * 128]; }
            const u32x4 pr = pack8(tr), pi = pack8(ti); Br[ks] = __builtin_bit_cast(bf16x8, pr); Bi[ks] = __builtin_bit_cast(bf16x8, pi); }
    }
    const float b_r = a.in[I_BR][l * D + ch], b_i = a.in[I_BI][l * D + ch];
    float cl; { const float lam = a.in[I_LAM][l * D + ch]; cl = -8.0f * log1pf(__expf(-lam)); }
    __syncthreads();
    f32x4 ar[16], ai_[16];
#pragma unroll
    for (int mt = 0; mt < 16; ++mt) { ar[mt] = (f32x4){0.f, 0.f, 0.f, 0.f}; ai_[mt] = (f32x4){0.f, 0.f, 0.f, 0.f}; }
    {
        const int abase = ((fr >> 2) * 64 + (fr & 3)) * 256;
#pragma unroll
        for (int mt = 0; mt < 16; ++mt)
#pragma unroll
            for (int ks = 0; ks < 4; ++ks) {
                const bf16x8 af = *(const LAS bf16x8*)(lds + abase + mt * 1024 + 16 * ((4 * ks + fq) ^ fr));
                ar[mt] = __builtin_amdgcn_mfma_f32_16x16x32_bf16(af, Br[ks], ar[mt], 0, 0, 0);
                ai_[mt] = __builtin_amdgcn_mfma_f32_16x16x32_bf16(af, Bi[ks], ai_[mt], 0, 0, 0);
            }
    }
    {
        int cbase[4];
#pragma unroll
        for (int j = 0; j < 4; ++j) cbase[j] = (64 * fq) * 256 + 16 * (((chl >> 3) ^ (fq << 2)) ^ j) + 2 * (fr & 7);
#pragma unroll
        for (int mt = 0; mt < 16; ++mt)
#pragma unroll
            for (int j = 0; j < 4; ++j) {
                const float r = fast_sigmoid(ar[mt][j] + b_r), ig = fast_sigmoid(ai_[mt][j] + b_i);
                const float la = cl * r;
                const float aa = __builtin_amdgcn_exp2f(la * 1.44269504089f);
                const float x2 = la + la;
                float om = 1.0f - aa * aa;
                if (x2 > -0.03f) om = -x2 * (1.0f + x2 * (0.5f + x2 * (0.16666667f + x2 * 0.041666668f)));
                float mult = __builtin_amdgcn_sqrtf(om > 0.f ? om : 0.f);
                if (mode == 2 && fq == 0 && j == 0 && (mt == 0 || mt == 4)) mult = 1.0f;
                const float ca = __uint_as_float((unsigned)(*(const LAS unsigned short*)(lds + cbase[j] + (4 * mt + j) * 256)) << 16);
                ar[mt][j] = aa; ai_[mt][j] = mult * ig * ca;
            }
    }
    float hs = 0.f;
    if (mode == 0) {
        float A = 1.f, H = 0.f;
#pragma unroll
        for (int mt = 0; mt < 16; ++mt)
#pragma unroll
            for (int j = 0; j < 4; ++j) { H = ar[mt][j] * H + ai_[mt][j]; A *= ar[mt][j]; }
        const float A0 = __shfl(A, fr), A1 = __shfl(A, fr + 16), A2 = __shfl(A, fr + 32), A3 = __shfl(A, fr + 48);
        const float H0 = __shfl(H, fr), H1 = __shfl(H, fr + 16), H2 = __shfl(H, fr + 32), H3 = __shfl(H, fr + 48);
        if (!FINAL) {
            if (fq == 0) { sumA[(size_t)pm * D + ch] = (A0 * A1) * (A2 * A3); sumH[(size_t)pm * D + ch] = ((H0 * A1 + H1) * A2 + H2) * A3 + H3; }
        } else {
            const int b = pm >> 5, c = pm & 31;
            float hc = sumH[(size_t)(66 + b) * D + ch];
            for (int cc = 0; cc < c; ++cc) hc = sumA[(size_t)(b * 32 + cc) * D + ch] * hc + sumH[(size_t)(b * 32 + cc) * D + ch];
            hs = hc;
            if (fq >= 1) hs = A0 * hs + H0;
            if (fq >= 2) hs = A1 * hs + H1;
            if (fq >= 3) hs = A2 * hs + H2;
        }
    }
    if (FINAL || mode == 2) {
        const float* slru = a.in[I_SLRU] + (size_t)l * 16 * D + ch;
        const int s0 = 8 * (pm - 64) + 2 * fq;
        float hcur = hs;
        if (mode == 1) hcur = slru[(size_t)s0 * D];
        float hm0 = 0.f, hm1 = 0.f;
#pragma unroll
        for (int mt = 0; mt < 16; ++mt) {
            if (mode == 1 && mt == 8) hcur = slru[(size_t)(s0 + 1) * D];
            if (mode == 2 && mt == 4) hcur = 0.f;
#pragma unroll
            for (int j = 0; j < 4; ++j) {
                hcur = ar[mt][j] * hcur + ai_[mt][j];
                if (FINAL) *(LAS unsigned short*)(lds + 65536 + (64 * fq + 4 * mt + j) * 256 + 2 * chl) = (unsigned short)(cvt_pk_bf16(hcur, 0.f) & 0xffffu);
            }
            if (mt == 3) hm0 = hcur;
            if (mt == 7) hm1 = hcur;
        }
        if (!FINAL) { if (fq == 0) { sumH[(size_t)66 * D + ch] = hm0; sumH[(size_t)67 * D + ch] = hm1; } }
        else {
            if (mode == 0 && (pm & 31) == 31 && fq == 3) a.out[O_LRU_P + (size_t)(l * 2 + (pm >> 5)) * D + ch] = hcur;
            if (mode == 1) { a.out[O_LRU_S + (size_t)(l * 16 + s0) * D + ch] = hm1; a.out[O_LRU_S + (size_t)(l * 16 + s0 + 1) * D + ch] = hcur; }
        }
    }
    __syncthreads();
    if (FINAL) {
#pragma unroll
        for (int it = 0; it < 8; ++it) { const int idx = tid + 512 * it, rho = idx >> 4, c8 = idx & 15;
            *(u32x4*)(PA + (size_t)(pm * 256 + rho) * D + h * 128 + 8 * c8) = *(const LAS u32x4*)(lds + 65536 + rho * 256 + 16 * c8); }
        __syncthreads();
    }
}

__device__ __forceinline__ void phase_final(const Args& a, int gw, int NGW, int lane) {
    const float* ssq = (const float*)(a.ws + WS_SSQ) + 4 * MP;
    for (int r = gw; r < ROW_M0; r += NGW) {
        const float rs = __builtin_amdgcn_rsqf(ssq[r] * (1.0f / D) + EPS);
        f32x4* xr = (f32x4*)(a.out + (size_t)r * D);
#pragma unroll
        for (int j = 0; j < 4; ++j) { const f32x4 gg = ((const f32x4*)a.in[I_FING])[lane + 64 * j]; f32x4 v = xr[lane + 64 * j]; v = v * rs * gg; xr[lane + 64 * j] = v; }
    }
}

constexpr int N_PHASES = 20;
#ifndef PH_MASK
#define PH_MASK 0xFFFF
#endif
#define PT(t) ((PH_MASK >> (t)) & 1)
__global__ void __launch_bounds__(NWAVES * 64, 2) fwd_kernel(Args args) {
    extern __shared__ __attribute__((aligned(16))) unsigned char lds_raw[];
    LAS unsigned char* lds = (LAS unsigned char*)lds_raw;
    {
        const int tid0 = threadIdx.x;
        for (int u = tid0; u < (LDS_BYTES - LDSCTL_OFF) / 4; u += NWAVES * 64) ((LAS unsigned*)(lds + LDSCTL_OFF))[u] = 0u;
        __syncthreads();
    }
    XcdBarrier bar; bar.bar = (unsigned*)(args.ws + WS_CTL) + CW_BAR; bar.x = 0; bar.st = (volatile LAS unsigned*)(lds + MISC_OFF) + 8;
    if (!MK_PER_PHASE) bar = xcd_barrier_post(bar.bar, bar.st);
    const int lo = args.ph_lo, hi = args.ph_hi;
#pragma unroll 1
    for (int ph = lo; ph < hi; ++ph) {
        int tid = threadIdx.x; asm volatile("" : "+v"(tid));
        const int lane = tid & 63, wave = __builtin_amdgcn_readfirstlane(tid >> 6);
        const int G = gridDim.x, bx = blockIdx.x;
        const int vcu = (G % 8 == 0) ? (bx % 8) * (G / 8) + bx / 8 : bx;
        const int gw = vcu * NWAVES + wave, NGW = G * NWAVES;
        float* ssq = (float*)(args.ws + WS_SSQ);
        bf16_t* XBUF = (bf16_t*)(args.ws + WS_XBUF);
        bf16_t* PA = (bf16_t*)(args.ws + WS_PA);
        const int l = ph >= 10 ? 1 : 0;
        const int pt = ph == 0 ? 0 : (ph == 19 ? 10 : ph - 9 * l);
        bool seam = true;
        switch (pt) {
        case 0: if (PT(0)) { phase_init(args, gw, NGW, lane); seam = false; } break;
        case 1: if (PT(1)) { phase_weights(args, l, lds, gw, NGW, wave, lane); } break;
        case 2: if (PT(2)) {
            pg8::Gemm g{XBUF, (const bf16_t*)(args.ws + W_IN), MP, NIN, D, D, 0}; pg8::StaticOrder S; S.init(MP, NIN, G, bx);
            EpiIn E{PA, (bf16_t*)(args.ws + WS_HALOA), ssq + (size_t)(2 * l) * MP, args.out, l};
            pg8::gemm_phase(lds, g, S, E); } break;
        case 3: if (PT(3)) {
            constexpr int NL = 65 * 8;
            for (int u = vcu; u < NL + NTILE; u += G) {
                if (u < NL) { const int t = u >> 3; lru_unit<false>(args, l, t < 64 ? t : 66, u & 7, lds, tid, wave, lane); }
                else pool_unit(args, l, u - NL, wave, lane);
            } } break;
        case 4: if (PT(4)) {
            for (int u = vcu; u < NTILE * 8; u += G) lru_unit<true>(args, l, u >> 3, u & 7, lds, tid, wave, lane);
            pg8::Gemm g{XBUF, (const bf16_t*)(args.ws + W_POOL), MP, D, 256, D, 256}; pg8::StaticOrder S; S.init(MP, D, G, bx);
            EpiStore E{(bf16_t*)(args.ws + WS_YB), D};
            pg8::gemm_phase(lds, g, S, E); } break;
        case 5: if (PT(5)) {
            pg8::Gemm g{PA, (const bf16_t*)(args.ws + W_BRA), MP, D, D, D, 0}; pg8::StaticOrder S; S.init(MP, D, G, bx);
            EpiGate<false> E{(const bf16_t*)(args.ws + WS_PGA), nullptr, XBUF};
            pg8::gemm_phase(lds, g, S, E); } break;
        case 6: if (PT(6)) {
            pg8::Gemm g{(const bf16_t*)(args.ws + WS_YB), (const bf16_t*)(args.ws + W_BRB), MP, D, D, D, 0}; pg8::StaticOrder S; S.init(MP, D, G, bx);
            EpiGate<true> E{(const bf16_t*)(args.ws + WS_PGB), XBUF, PA};
            pg8::gemm_phase(lds, g, S, E); } break;
        case 7: if (PT(7)) {
            pg8::Gemm g{PA, (const bf16_t*)(args.ws + W_OUT), MP, D, D, D, 0}; pg8::StaticOrder S; S.init(MP, D, G, bx);
            EpiRes E{args.out, (float*)(args.ws + WS_XMETA), XBUF, ssq + (size_t)(2 * l + 1) * MP};
            pg8::gemm_phase(lds, g, S, E); } break;
        case 8: if (PT(8)) {
            pg8::Gemm g{XBUF, (const bf16_t*)(args.ws + W_GU), MP, NGU, D, D, 0}; pg8::StaticOrder S; S.init(MP, NGU, G, bx);
            EpiGU E{PA, ssq + (size_t)(2 * l + 1) * MP};
            pg8::gemm_phase(lds, g, S, E); } break;
        case 9: if (PT(9)) {
            pg8::Gemm g{PA, (const bf16_t*)(args.ws + W_DN), MP, D, DFF, DFF, 0}; pg8::StaticOrder S; S.init(MP, D, G, bx);
            EpiRes E{args.out, (float*)(args.ws + WS_XMETA), XBUF, ssq + (size_t)(2 * l + 2) * MP};
            pg8::gemm_phase(lds, g, S, E); } break;
        default: if (PT(10)) { phase_final(args, gw, NGW, lane); } break;
        }
        __syncthreads();
        if (seam && ph + 1 < hi) xcd_barrier(bar);
    }
}

extern "C" void kernel_launch(void* const* d_in, const int* in_sizes, int n_in, void* d_out, int out_size, void* d_ws, size_t ws_size, hipStream_t stream) {
    static int grid = 0;
    if (grid == 0) {
        if (n_in != 24 || (size_t)out_size != O_END || ws_size < WS_END) { fprintf(stderr, "kernel_launch: unexpected shapes (n_in %d out %d ws %zu)\n", n_in, out_size, ws_size); grid = -1; return; }
        int dev = 0, cus = 0, per_cu = 0;
        if (hipGetDevice(&dev) != hipSuccess || hipDeviceGetAttribute(&cus, hipDeviceAttributeMultiprocessorCount, dev) != hipSuccess) { grid = -1; return; }
        if (hipFuncSetAttribute((const void*)fwd_kernel, hipFuncAttributeMaxDynamicSharedMemorySize, LDS_BYTES) != hipSuccess) { fprintf(stderr, "kernel_launch: hipFuncSetAttribute failed\n"); grid = -1; return; }
        if (hipOccupancyMaxActiveBlocksPerMultiprocessor(&per_cu, (const void*)fwd_kernel, NWAVES * 64, LDS_BYTES) != hipSuccess || per_cu < 1) { fprintf(stderr, "kernel_launch: occupancy query says %d\n", per_cu); (void)hipGetLastError(); grid = -1; return; }
        grid = cus;
    }
    if (grid < 0) return;
    (void)hipMemsetAsync((char*)d_ws + WS_CTL, 0, CTL_ZERO_BYTES, stream);
    Args a{};
    for (int i = 0; i < 24; ++i) a.in[i] = (const float*)d_in[i];
    a.out = (float*)d_out; a.ws = (unsigned char*)d_ws;
#if MK_PER_PHASE
    for (int p = 0; p < N_PHASES; ++p) { a.ph_lo = p; a.ph_hi = p + 1; hipLaunchKernelGGL(fwd_kernel, dim3(grid), dim3(NWAVES * 64), LDS_BYTES, stream, a); }
#else
    a.ph_lo = 0; a.ph_hi = N_PHASES;
    void* kargs[] = {&a};
    hipError_t e = hipLaunchCooperativeKernel((const void*)fwd_kernel, dim3(grid), dim3(NWAVES * 64), kargs, LDS_BYTES, stream);
    if (e != hipSuccess) fprintf(stderr, "kernel_launch: cooperative launch failed: %s (grid %d)\n", hipGetErrorString(e), grid);
#endif
}
```

```cpp
#include <hip/hip_runtime.h>
#include <cstdio>
#include <cstdint>

#ifndef MK_PER_PHASE
#define MK_PER_PHASE 0
#endif

#define GAS __attribute__((address_space(1)))
#define LAS __attribute__((address_space(3)))

typedef unsigned short bf16_t;
typedef short bf16x8 __attribute__((ext_vector_type(8)));
typedef float f32x4 __attribute__((ext_vector_type(4)));
typedef float f32x2 __attribute__((ext_vector_type(2)));
typedef unsigned u32x4 __attribute__((ext_vector_type(4)));
typedef unsigned u32x2 __attribute__((ext_vector_type(2)));

constexpr int D = 1024, DFF = 2816, NGU = 2 * DFF, NIN = 4096;
constexpr int SEQ = 8192, DEC_B = 16, DEC_T = 32, DEPTH = 2;
constexpr int ROWS_P = 2 * SEQ;
constexpr int ROWS_S = DEC_B * DEC_T;
constexpr int ROW_M0 = ROWS_P + ROWS_S;
constexpr int MP = 17152, NTILE = 67;
constexpr float EPS = 1e-6f;

constexpr size_t O_YS = (size_t)ROWS_P * D;
constexpr size_t O_CONV_P = O_YS + (size_t)ROWS_S * D;
constexpr size_t O_LRU_P = O_CONV_P + (size_t)DEPTH * 2 * 3 * D;
constexpr size_t O_POOL_P = O_LRU_P + (size_t)DEPTH * 2 * D;
constexpr size_t O_CONV_S = O_POOL_P + (size_t)DEPTH * 2 * 15 * D;
constexpr size_t O_LRU_S = O_CONV_S + (size_t)DEPTH * 16 * 3 * D;
constexpr size_t O_POOL_S = O_LRU_S + (size_t)DEPTH * 16 * D;
constexpr size_t O_END = O_POOL_S + (size_t)DEPTH * 16 * 15 * D;

constexpr size_t MiB = 1u << 20;
constexpr size_t SZ_ACT = (size_t)MP * D * 2;
constexpr size_t WS_CTL = 0, CTL_ZERO_BYTES = 1 * MiB;
constexpr size_t WS_SSQ = 64 * 1024;
constexpr size_t WS_SUM = 1 * MiB;
constexpr size_t WS_HALOA = 2 * MiB;
constexpr size_t WS_XMETA = 3 * MiB;
constexpr size_t WS_W = 4 * MiB;
constexpr size_t W_IN = WS_W, W_GU = W_IN + 8 * MiB, W_DN = W_GU + 11 * MiB, W_BRA = W_DN + 5632 * 1024, W_BRB = W_BRA + 2 * MiB, W_OUT = W_BRB + 2 * MiB, W_POOL = W_OUT + 2 * MiB;
constexpr size_t WS_XBUF = 36 * MiB;
constexpr size_t WS_PA = 70 * MiB, WS_PB = WS_PA + SZ_ACT, WS_PGA = WS_PB + SZ_ACT, WS_PGB = WS_PGA + SZ_ACT;
constexpr size_t WS_YB = WS_PGB + SZ_ACT;
constexpr size_t WS_END = WS_YB + SZ_ACT;
static_assert(W_POOL + 512 * 1024 <= WS_XBUF && WS_XBUF + SZ_ACT <= WS_PA && WS_END <= 256 * MiB, "d_ws map");
static_assert((size_t)MP * DFF * 2 <= 4 * SZ_ACT, "H overlay");
constexpr int CW_TMO = 0, CW_BAR = 4096;

constexpr int RING_BYTES = 131072, LDSCTL_OFF = RING_BYTES, MISC_OFF = LDSCTL_OFF + 320, LDS_BYTES = 147456;
constexpr int NWAVES = 8;

__device__ __forceinline__ unsigned cvt_pk_bf16(float lo, float hi) { unsigned r; asm volatile("v_cvt_pk_bf16_f32 %0, %1, %2" : "=v"(r) : "v"(lo), "v"(hi)); return r; }
__device__ __forceinline__ float bf_lo(unsigned w) { return __uint_as_float(w << 16); }
__device__ __forceinline__ float bf_hi(unsigned w) { return __uint_as_float(w & 0xffff0000u); }
__device__ __forceinline__ float fast_sigmoid(float v) { return __builtin_amdgcn_rcpf(1.0f + __builtin_amdgcn_exp2f(v * -1.44269504089f)); }
__device__ __forceinline__ float wave_sum(float v) {
#pragma unroll
    for (int o = 1; o < 64; o <<= 1) v += __shfl_xor(v, o);
    return v;
}
__device__ __forceinline__ void unpack8(const u32x4 w, float (&o)[8]) {
    o[0] = bf_lo(w.x); o[1] = bf_hi(w.x); o[2] = bf_lo(w.y); o[3] = bf_hi(w.y); o[4] = bf_lo(w.z); o[5] = bf_hi(w.z); o[6] = bf_lo(w.w); o[7] = bf_hi(w.w);
}
__device__ __forceinline__ u32x4 pack8(const float (&v)[8]) {
    u32x4 w; w.x = cvt_pk_bf16(v[0], v[1]); w.y = cvt_pk_bf16(v[2], v[3]); w.z = cvt_pk_bf16(v[4], v[5]); w.w = cvt_pk_bf16(v[6], v[7]); return w;
}
#define LDS_WAIT() asm volatile("s_waitcnt lgkmcnt(0)" ::: "memory")
#define VM_WAIT() asm volatile("s_waitcnt vmcnt(0)" ::: "memory")

namespace pg8 {
constexpr int BM = 256, BK = 64, HALF = 128, HTB = HALF * BK * 2, STAGE_BYTES = 8 * HTB, NXCD = 8, WGM = 8;
__host__ __device__ __forceinline__ int lds_byte(int r, int c) { const int st = (r >> 4) * 2 + (c >> 5), rr = r & 15, cc = c & 31, ob = rr * 64 + cc * 2; return st * 1024 + (ob ^ (((ob >> 9) & 1) << 5)); }
__host__ __device__ __forceinline__ void stage_rc(int b, int& R, int& C) { const int st = b / 1024, sb = b % 1024, swz = sb ^ (((sb >> 9) & 1) << 5); R = (st >> 1) * 16 + swz / 64; C = (st & 1) * 32 + (swz % 64) / 2; }
__host__ __device__ __forceinline__ int perm32(int rho) { const int n = rho >> 4, i = rho & 15; return 8 * (i >> 2) + 4 * n + (i & 3); }

struct Unit { int pm, pn; };
struct Gemm { const bf16_t* A; const bf16_t* Bt; int M, N, K, lda, a_pn_off; };

struct StaticOrder {
    int nM, nN, nwg, G, c;
    __device__ void init(int M, int N, int G_, int c_) { nM = M / BM; nN = N / BM; nwg = nM * nN; G = G_; c = c_; }
    __device__ bool next(int i, Unit& u) const {
        const long L = (long)i * G + c; if (L >= nwg) return false;
        int wgid = (int)L; { const int q = nwg / NXCD, r = nwg % NXCD, xcd = wgid % NXCD, off = wgid / NXCD; wgid = (xcd < r ? xcd * (q + 1) : r * (q + 1) + (xcd - r) * q) + off; }
        const int nig = WGM * nN, gid = wgid / nig, fm = gid * WGM, gsz = (nM - fm) < WGM ? (nM - fm) : WGM;
        u.pm = fm + ((wgid % nig) % gsz); u.pn = (wgid % nig) / gsz; return true;
    }
};

template <class Epi>
__device__ __forceinline__ void gemm_phase(LAS unsigned char* lds, const Gemm g, const StaticOrder& S, const Epi& E) {
    int tid_ = threadIdx.x; asm volatile("" : "+v"(tid_));
    const int tid = tid_, wid = __builtin_amdgcn_readfirstlane(tid >> 6), lane = tid & 63, wr = wid >> 2, wc = wid & 3, fr = lane & 15, fq = lane >> 4;
    const int K = g.K, nt = K / BK, lda = g.lda;
    unsigned voffA[2], voffB[2];
#pragma unroll
    for (int i = 0; i < 2; ++i) { int R, C; stage_rc(tid * 16 + i * 8192, R, C); const int Rb = (R & ~31) + perm32(R & 31);
        voffA[i] = (unsigned)(R * lda + C) * 2u; voffB[i] = (unsigned)(Rb * K + C) * 2u; }
    const size_t kstep = (size_t)(BK * 2);
    const size_t hstepA = (size_t)HALF * lda * 2, tstepA = 2 * hstepA;
    const size_t hstepB = (size_t)HALF * K * 2, tstepB = 2 * hstepB;
    const size_t pnoffA = (size_t)g.a_pn_off * 2;
    const unsigned ldsw = (unsigned)wid * 1024u;
    const int aoff = lds_byte(wr * 64 + fr, fq * 8), boff = lds_byte(wc * 32 + fr, fq * 8);
#define PG8_SA(b, h) (((b) * 2 + (h)) * HTB)
#define PG8_SB(b, h) ((4 + (b) * 2 + (h)) * HTB)
#define PG8_STAGE(bufoff, gbase, voff) do { _Pragma("unroll") for (int _i = 0; _i < 2; ++_i) \
        __builtin_amdgcn_global_load_lds((const unsigned*)((const char*)(gbase) + (voff)[_i]), (LAS unsigned*)(lds + (bufoff) + ldsw + _i * 8192), 16, 0, 0); } while (0)
#define PG8_LDA(dst, b, h) do { _Pragma("unroll") for (int m = 0; m < 4; ++m) _Pragma("unroll") for (int k = 0; k < 2; ++k) dst[m][k] = *(const LAS bf16x8*)(lds + PG8_SA(b, h) + aoff + m * 2048 + k * 1024); } while (0)
#define PG8_LDB(dst, b, h) do { _Pragma("unroll") for (int n = 0; n < 2; ++n) _Pragma("unroll") for (int k = 0; k < 2; ++k) dst[n][k] = *(const LAS bf16x8*)(lds + PG8_SB(b, h) + boff + n * 2048 + k * 1024); } while (0)
#define PG8_MMA(ai, bj, At, Bt) do { __builtin_amdgcn_s_setprio(1); _Pragma("unroll") for (int m = 0; m < 4; ++m) _Pragma("unroll") for (int n = 0; n < 2; ++n) _Pragma("unroll") for (int k = 0; k < 2; ++k) \
        acc[ai][bj][m][n] = __builtin_amdgcn_mfma_f32_16x16x32_bf16(Bt[n][k], At[m][k], acc[ai][bj][m][n], 0, 0, 0); __builtin_amdgcn_s_setprio(0); } while (0)
#define PG8_WAIT_V(n) asm volatile("s_waitcnt vmcnt(" #n ")" ::: "memory")
#define PG8_WAIT_L(n) asm volatile("s_waitcnt lgkmcnt(" #n ")" ::: "memory")
#define PG8_BAR __builtin_amdgcn_s_barrier()
#define PG8_SCHED __builtin_amdgcn_sched_barrier(0)
    Unit cur, nxt; int ui = 0;
    if (!S.next(0, cur)) return;
    f32x4 acc[2][2][4][2];
#pragma unroll
    for (int a = 0; a < 2; ++a)
#pragma unroll
        for (int b = 0; b < 2; ++b)
#pragma unroll
            for (int m = 0; m < 4; ++m)
#pragma unroll
                for (int n = 0; n < 2; ++n) acc[a][b][m][n] = (f32x4){0.f, 0.f, 0.f, 0.f};
    bf16x8 At[4][2], B0[2][2], B1[2][2];
    const char* cA = (const char*)g.A + (size_t)cur.pm * tstepA + (size_t)cur.pn * pnoffA; const char* cB = (const char*)g.Bt + (size_t)cur.pn * tstepB;
    PG8_STAGE(PG8_SB(0, 0), cB, voffB); PG8_STAGE(PG8_SB(0, 1), cB + hstepB, voffB); PG8_STAGE(PG8_SA(0, 0), cA, voffA); PG8_STAGE(PG8_SA(0, 1), cA + hstepA, voffA);
    if (wr == 1) PG8_BAR;
    PG8_WAIT_V(2); PG8_BAR;
    PG8_STAGE(PG8_SB(1, 0), cB + kstep, voffB); PG8_STAGE(PG8_SA(1, 0), cA + kstep, voffA); PG8_STAGE(PG8_SB(1, 1), cB + hstepB + kstep, voffB);
    PG8_WAIT_V(6); PG8_BAR;
    for (;;) {
        const bool has_next = S.next(ui + 1, nxt);
        const char* nA = has_next ? (const char*)g.A + (size_t)nxt.pm * tstepA + (size_t)nxt.pn * pnoffA : cA; const char* nB = has_next ? (const char*)g.Bt + (size_t)nxt.pn * tstepB : cB;
#pragma unroll 1
        for (int t = 0; t < nt; t += 2) {
            const bool last = (t == nt - 2);
            const char* a1 = cA + (size_t)(t + 1) * kstep;
            const char* a2 = last ? nA : cA + (size_t)(t + 2) * kstep; const char* b2 = last ? nB : cB + (size_t)(t + 2) * kstep;
            const char* a3 = a2 + kstep; const char* b3 = b2 + kstep;
            PG8_LDB(B0, 0, 0); PG8_LDB(B1, 0, 1); PG8_SCHED; PG8_LDA(At, 0, 0); PG8_STAGE(PG8_SA(1, 1), a1 + hstepA, voffA);
            PG8_WAIT_V(8); PG8_WAIT_L(0); PG8_BAR; PG8_MMA(0, 0, At, B0); PG8_MMA(0, 1, At, B1); PG8_BAR; PG8_SCHED;
            PG8_LDA(At, 0, 1); PG8_STAGE(PG8_SB(0, 0), b2, voffB); PG8_STAGE(PG8_SB(0, 1), b2 + hstepB, voffB); PG8_STAGE(PG8_SA(0, 0), a2, voffA);
            PG8_WAIT_V(8); PG8_WAIT_L(0); PG8_BAR; PG8_MMA(1, 0, At, B0); PG8_MMA(1, 1, At, B1); PG8_BAR; PG8_SCHED;
            PG8_LDB(B0, 1, 0); PG8_LDB(B1, 1, 1); PG8_SCHED; PG8_LDA(At, 1, 0); PG8_STAGE(PG8_SA(0, 1), a2 + hstepA, voffA);
            PG8_WAIT_V(8); PG8_WAIT_L(0); PG8_BAR; PG8_MMA(0, 0, At, B0); PG8_MMA(0, 1, At, B1); PG8_BAR; PG8_SCHED;
            PG8_LDA(At, 1, 1); PG8_STAGE(PG8_SB(1, 0), b3, voffB); PG8_STAGE(PG8_SB(1, 1), b3 + hstepB, voffB); PG8_STAGE(PG8_SA(1, 0), a3, voffA);
            PG8_WAIT_V(8); PG8_WAIT_L(0); PG8_BAR; PG8_MMA(1, 0, At, B0); PG8_MMA(1, 1, At, B1); PG8_BAR; PG8_SCHED;
        }
        if (wr == 0) PG8_BAR;
        { int fr_e = fr, fq_e = fq; asm volatile("" : "+v"(fr_e), "+v"(fq_e)); E(acc, cur, wr, wc, fr_e, fq_e); }
        if (!has_next) break;
#pragma unroll
        for (int a = 0; a < 2; ++a)
#pragma unroll
            for (int b = 0; b < 2; ++b)
#pragma unroll
                for (int m = 0; m < 4; ++m)
#pragma unroll
                    for (int n = 0; n < 2; ++n) acc[a][b][m][n] = (f32x4){0.f, 0.f, 0.f, 0.f};
        cur = nxt; cA = nA; cB = nB; ++ui;
        if (wr == 1) PG8_BAR;
    }
    PG8_WAIT_V(0);
    PG8_BAR;
#undef PG8_SA
#undef PG8_SB
#undef PG8_STAGE
#undef PG8_LDA
#undef PG8_LDB
#undef PG8_MMA
#undef PG8_WAIT_V
#undef PG8_WAIT_L
#undef PG8_BAR
#undef PG8_SCHED
}
}

#define EPI_ROWS_BEGIN _Pragma("unroll") for (int ai = 0; ai < 2; ++ai) _Pragma("unroll") for (int m = 0; m < 4; ++m) { const int lr = ai * 128 + wr * 64 + m * 16 + fr; const int row = u.pm * 256 + lr; (void)row;
#define EPI_ROWS_END asm volatile("" ::: "memory"); }

struct EpiIn {
    bf16_t* P;
    bf16_t* haloA;
    const float* ssq;
    float* out;
    int layer;
    __device__ __forceinline__ void operator()(const f32x4 (&acc)[2][2][4][2], const pg8::Unit& u, int wr, int wc, int fr, int fq) const {
        const int t = u.pn >> 2;
        bf16_t* base = P + (size_t)t * (SZ_ACT / 2);
        const int lc0 = (u.pn & 3) * 256 + wc * 32 + 8 * fq;
        const bool special = (t < 2);
        EPI_ROWS_BEGIN
            const float rs = __builtin_amdgcn_rsqf(ssq[row] * (1.0f / D) + EPS);
#pragma unroll
            for (int bj = 0; bj < 2; ++bj) {
                float v[8];
#pragma unroll
                for (int n = 0; n < 2; ++n)
#pragma unroll
                    for (int e = 0; e < 4; ++e) { float x = acc[ai][bj][m][n][e] * rs; if (t >= 2) x = fast_sigmoid(x); v[n * 4 + e] = x; }
                const u32x4 w = pack8(v);
                const int lc = lc0 + bj * 128;
                *(u32x4*)(base + (size_t)row * D + lc) = w;
                if (special) {
                    if (t == 0) {
                        if (u.pm < 64) { if ((u.pm & 31) != 31 && lr >= 253) *(u32x4*)(haloA + ((size_t)(u.pm + 1) * 3 + (lr - 253)) * D + lc) = w; }
                        else if (u.pm == 66) { if (lr >= 13 && lr < 16) *(u32x4*)(haloA + ((size_t)0 * 3 + (lr - 13)) * D + lc) = w;
                                               if (lr >= 29 && lr < 32) *(u32x4*)(haloA + ((size_t)32 * 3 + (lr - 29)) * D + lc) = w; }
                        float* o = nullptr;
                        if (u.pm < 64) { if ((u.pm & 31) == 31 && lr >= 253) o = out + O_CONV_P + ((size_t)(layer * 2 + (u.pm >> 5)) * 3 + (lr - 253)) * D + lc; }
                        else if (u.pm < 66) { const int ts = lr & 31; if (ts >= 29) o = out + O_CONV_S + ((size_t)(layer * 16 + 8 * (u.pm - 64) + (lr >> 5)) * 3 + (ts - 29)) * D + lc; }
                        if (o) { *(f32x4*)o = (f32x4){v[0], v[1], v[2], v[3]}; *(f32x4*)(o + 4) = (f32x4){v[4], v[5], v[6], v[7]}; }
                    } else {
                        float* o = nullptr;
                        if (u.pm < 64) { if ((u.pm & 31) == 31 && lr >= 241) o = out + O_POOL_P + ((size_t)(layer * 2 + (u.pm >> 5)) * 15 + (lr - 241)) * D + lc; }
                        else if (u.pm < 66) { const int ts = lr & 31; if (ts >= 17) o = out + O_POOL_S + ((size_t)(layer * 16 + 8 * (u.pm - 64) + (lr >> 5)) * 15 + (ts - 17)) * D + lc; }
                        if (o) { *(f32x4*)o = (f32x4){v[0], v[1], v[2], v[3]}; *(f32x4*)(o + 4) = (f32x4){v[4], v[5], v[6], v[7]}; }
                    }
                }
            }
        EPI_ROWS_END
    }
};

struct EpiStore {
    bf16_t* O; int ldc;
    __device__ __forceinline__ void operator()(const f32x4 (&acc)[2][2][4][2], const pg8::Unit& u, int wr, int wc, int fr, int fq) const {
        const int c0 = u.pn * 256 + wc * 32 + 8 * fq;
        EPI_ROWS_BEGIN
#pragma unroll
            for (int bj = 0; bj < 2; ++bj) {
                float v[8];
#pragma unroll
                for (int n = 0; n < 2; ++n)
#pragma unroll
                    for (int e = 0; e < 4; ++e) v[n * 4 + e] = acc[ai][bj][m][n][e];
                *(u32x4*)(O + (size_t)row * ldc + c0 + bj * 128) = pack8(v);
            }
        EPI_ROWS_END
    }
};

template <bool SECOND> struct EpiGate {
    const bf16_t* gate; const bf16_t* t1; bf16_t* O;
    __device__ __forceinline__ void operator()(const f32x4 (&acc)[2][2][4][2], const pg8::Unit& u, int wr, int wc, int fr, int fq) const {
        const int c0 = u.pn * 256 + wc * 32 + 8 * fq;
        EPI_ROWS_BEGIN
#pragma unroll
            for (int bj = 0; bj < 2; ++bj) {
                const size_t off = (size_t)row * D + c0 + bj * 128;
                float gv[8], v[8]; unpack8(*(const u32x4*)(gate + off), gv);
                if (SECOND) { float tv[8]; unpack8(*(const u32x4*)(t1 + off), tv);
#pragma unroll
                    for (int n = 0; n < 2; ++n)
#pragma unroll
                        for (int e = 0; e < 4; ++e) v[n * 4 + e] = tv[n * 4 + e] + gv[n * 4 + e] * acc[ai][bj][m][n][e];
                } else {
#pragma unroll
                    for (int n = 0; n < 2; ++n)
#pragma unroll
                        for (int e = 0; e < 4; ++e) v[n * 4 + e] = gv[n * 4 + e] * acc[ai][bj][m][n][e];
                }
                *(u32x4*)(O + off) = pack8(v);
            }
        EPI_ROWS_END
    }
};

struct EpiRes {
    float* xmain; float* xmeta; bf16_t* xb; float* ssq_next;
    __device__ __forceinline__ void operator()(const f32x4 (&acc)[2][2][4][2], const pg8::Unit& u, int wr, int wc, int fr, int fq) const {
        const int c0 = u.pn * 256 + wc * 32 + 8 * fq;
        float* xbase = (u.pm < 66) ? xmain + (size_t)u.pm * 256 * D : xmeta;
        EPI_ROWS_BEGIN
            float s = 0.f;
#pragma unroll
            for (int bj = 0; bj < 2; ++bj) {
                float* xp = xbase + (size_t)lr * D + c0 + bj * 128;
                const f32x4 x0 = *(const f32x4*)xp, x1 = *(const f32x4*)(xp + 4);
                float v[8];
#pragma unroll
                for (int e = 0; e < 4; ++e) { v[e] = x0[e] + acc[ai][bj][m][0][e]; v[4 + e] = x1[e] + acc[ai][bj][m][1][e]; }
#pragma unroll
                for (int e = 0; e < 8; ++e) s += v[e] * v[e];
                *(f32x4*)xp = (f32x4){v[0], v[1], v[2], v[3]}; *(f32x4*)(xp + 4) = (f32x4){v[4], v[5], v[6], v[7]};
                *(u32x4*)(xb + (size_t)row * D + c0 + bj * 128) = pack8(v);
            }
            s += __shfl_xor(s, 16); s += __shfl_xor(s, 32);
            if (fq == 0) atomicAdd(ssq_next + row, s);
        EPI_ROWS_END
    }
};

struct EpiGU {
    bf16_t* H; const float* ssq;
    __device__ __forceinline__ void operator()(const f32x4 (&acc)[2][2][4][2], const pg8::Unit& u, int wr, int wc, int fr, int fq) const {
        const int c0 = u.pn * 128 + wc * 32 + 8 * fq;
        EPI_ROWS_BEGIN
            const float rs = __builtin_amdgcn_rsqf(ssq[row] * (1.0f / D) + EPS);
            float v[8];
#pragma unroll
            for (int n = 0; n < 2; ++n)
#pragma unroll
                for (int e = 0; e < 4; ++e) { const float gg = acc[ai][0][m][n][e] * rs, uu = acc[ai][1][m][n][e] * rs; v[n * 4 + e] = gg * fast_sigmoid(gg) * uu; }
            *(u32x4*)(H + (size_t)row * DFF + c0) = pack8(v);
        EPI_ROWS_END
    }
};

#define XB_TMO      128
#define XB_XCNT(j)  (256  + 64 * (j))
#define XB_XSUB(j)  (1280 + 64 * (j))
#define XB_XGEN(j)  (2304 + 64 * (j))
#define XB_TOP      3328
#define XB_TOPGEN   3392
#define XCD_BAR_WORDS 3456
#define XB_SPIN_CAP (1u << 20)
__device__ __forceinline__ unsigned xb_ld(unsigned* p)              { return __hip_atomic_load(p, __ATOMIC_RELAXED, __HIP_MEMORY_SCOPE_AGENT); }
__device__ __forceinline__ unsigned xb_add(unsigned* p, unsigned v) { return __hip_atomic_fetch_add(p, v, __ATOMIC_RELAXED, __HIP_MEMORY_SCOPE_AGENT); }
__device__ __forceinline__ unsigned xb_xcc_id() { return (unsigned)__builtin_amdgcn_s_getreg((3 << 11) | 20) & 0xFu; }
#define XB_SPIN(cond, bar) do { unsigned _sp = 0; while (cond) { __builtin_amdgcn_s_sleep(1); \
    if ((++_sp & 255u) == 0u) { if (xb_ld(&(bar)[XB_TMO])) break; if (_sp > XB_SPIN_CAP) { atomicAdd(&(bar)[XB_TMO], 1u); break; } } } } while (0)
struct XcdBarrier { unsigned* bar; unsigned x; volatile LAS unsigned* st; };
__device__ __forceinline__ XcdBarrier xcd_barrier_post(unsigned* bar, volatile LAS unsigned* st) {
    XcdBarrier b; b.bar = bar; b.x = xb_xcc_id(); b.st = st;
    if (threadIdx.x == 0) (void)xb_add(&bar[XB_XCNT(b.x)], 1u);
    return b;
}
__device__ __forceinline__ void xcd_barrier_complete(unsigned* bar, unsigned x, unsigned& nloc, unsigned& nx) {
    const unsigned G = gridDim.x * gridDim.y * gridDim.z;
    unsigned sum, cnt, mine, sp = 0u;
    for (;;) {
        sum = 0u; cnt = 0u; mine = 0u;
#pragma unroll
        for (unsigned j = 0; j < 16; ++j) { const unsigned c = xb_ld(&bar[XB_XCNT(j)]); sum += c; cnt += (c > 0u) ? 1u : 0u; mine = (j == x) ? c : mine; }
        if (sum == G) break;
        __builtin_amdgcn_s_sleep(1);
        if ((++sp & 255u) == 0u) { if (xb_ld(&bar[XB_TMO])) break; if (sp > XB_SPIN_CAP) { atomicAdd(&bar[XB_TMO], 1u); break; } }
    }
    nloc = mine > 0u ? mine : 1u; nx = cnt > 0u ? cnt : 1u;
}
__device__ __forceinline__ void xcd_barrier(const XcdBarrier& b) {
    asm volatile("s_waitcnt vmcnt(0)" ::: "memory");
    __syncthreads();
    if (threadIdx.x == 0) {
        unsigned* bar = b.bar;
        __builtin_amdgcn_s_waitcnt(0);
        unsigned nloc = b.st[0], nx = b.st[1];
        if (nloc == 0u) { xcd_barrier_complete(bar, b.x, nloc, nx); b.st[0] = nloc; b.st[1] = nx; }
        const unsigned old = xb_add(&bar[XB_XSUB(b.x)], 1u);
        const unsigned gen = old / nloc;
        if (old + 1u == (gen + 1u) * nloc) {
            __builtin_amdgcn_fence(__ATOMIC_RELEASE, "agent");
            asm volatile("s_waitcnt vmcnt(0)" ::: "memory");
            const unsigned og = xb_add(&bar[XB_TOP], 1u);
            const unsigned tg = og / nx;
            if (og + 1u == (tg + 1u) * nx) xb_add(&bar[XB_TOPGEN], 1u);
            else XB_SPIN(xb_ld(&bar[XB_TOPGEN]) == tg, bar);
            __builtin_amdgcn_fence(__ATOMIC_ACQUIRE, "agent");
            xb_add(&bar[XB_XGEN(b.x)], 1u);
            asm volatile("s_waitcnt vmcnt(0)" ::: "memory");
        } else {
            XB_SPIN(xb_ld(&bar[XB_XGEN(b.x)]) == gen, bar);
            __builtin_amdgcn_fence(__ATOMIC_ACQUIRE, "agent");
            asm volatile("s_waitcnt vmcnt(0)" ::: "memory");
        }
    }
    __syncthreads();
}

struct Args { const float* in[24]; float* out; unsigned char* ws; int ph_lo, ph_hi; };
enum { I_XP = 0, I_XS, I_SCONV, I_SLRU, I_SPOOL, I_META, I_N1G, I_WIN, I_CONVW, I_CONVB, I_LAM, I_WR, I_BR, I_WI, I_BI, I_POOLW, I_POOLS, I_WBRA, I_WBRB, I_WOUT, I_N2G, I_WGU, I_WDN, I_FING };

__device__ __forceinline__ void phase_init(const Args& a, int gw, int NGW, int lane) {
    float* xmeta = (float*)(a.ws + WS_XMETA); bf16_t* xb = (bf16_t*)(a.ws + WS_XBUF); float* ssq0 = (float*)(a.ws + WS_SSQ);
    for (int r = gw; r < MP; r += NGW) {
        const float* src; float* dst;
        if (r < ROWS_P) { src = a.in[I_XP] + (size_t)r * D; dst = a.out + (size_t)r * D; }
        else if (r < ROW_M0) { src = a.in[I_XS] + (size_t)(r - ROWS_P) * D; dst = a.out + (size_t)r * D; }
        else if (r < ROW_M0 + 32) { src = a.in[I_META] + (size_t)((r - ROW_M0) & 15) * D; dst = xmeta + (size_t)(r - ROW_M0) * D; }
        else { src = nullptr; dst = xmeta + (size_t)(r - ROW_M0) * D; }
        f32x4 v[4]; float s = 0.f;
#pragma unroll
        for (int j = 0; j < 4; ++j) { v[j] = src ? ((const f32x4*)src)[lane + 64 * j] : (f32x4){0.f, 0.f, 0.f, 0.f}; s += (v[j].x * v[j].x + v[j].y * v[j].y) + (v[j].z * v[j].z + v[j].w * v[j].w); }
        s = wave_sum(s);
#pragma unroll
        for (int j = 0; j < 4; ++j) { ((f32x4*)dst)[lane + 64 * j] = v[j];
            u32x2 w; w.x = cvt_pk_bf16(v[j].x, v[j].y); w.y = cvt_pk_bf16(v[j].z, v[j].w); ((u32x2*)(xb + (size_t)r * D))[lane + 64 * j] = w; }
        if (lane == 0) ssq0[r] = s;
    }
}

__device__ __forceinline__ void tr_item(const float* W, int K, int N, bf16_t* WT, int k0, int n0, int row0, const float* kscale, const float* nscale, LAS float* scr, int lane) {
#pragma unroll 8
    for (int i = 0; i < 32; ++i) { const int kk = 2 * i + (lane >> 5); float v = W[(size_t)(k0 + kk) * N + n0 + (lane & 31)]; if (kscale) v *= kscale[k0 + kk]; if (nscale) v *= nscale[n0 + (lane & 31)]; scr[kk * 33 + (lane & 31)] = v; }
    LDS_WAIT(); asm volatile("" ::: "memory");
    const int c = lane & 7;
#pragma unroll
    for (int j = 0; j < 4; ++j) { const int n = (lane >> 3) + 8 * j; const LAS float* s = scr + (8 * c) * 33 + n;
        u32x4 o; o.x = cvt_pk_bf16(s[0 * 33], s[1 * 33]); o.y = cvt_pk_bf16(s[2 * 33], s[3 * 33]); o.z = cvt_pk_bf16(s[4 * 33], s[5 * 33]); o.w = cvt_pk_bf16(s[6 * 33], s[7 * 33]);
        *(u32x4*)(WT + (size_t)(row0 + n) * K + k0 + 8 * c) = o; }
    LDS_WAIT(); asm volatile("" ::: "memory");
}
__device__ __forceinline__ void phase_weights(const Args& a, int l, LAS unsigned char* lds, int gw, int NGW, int wave, int lane) {
    LAS float* scr = (LAS float*)(lds + wave * 16384);
    constexpr int I_IN = 16 * 128, I_GU = 16 * 176, I_DN = 44 * 32, I_SQ = 16 * 32, I_PL = 4 * 8;
    constexpr int NITEMS = I_IN + I_GU + I_DN + 3 * I_SQ + 4 * I_PL;
    for (int it = gw; it < NITEMS; it += NGW) {
        int r = it;
        if (r < I_IN) { const int kb = r / 128, nb = r % 128; tr_item(a.in[I_WIN] + (size_t)l * D * NIN, D, NIN, (bf16_t*)(a.ws + W_IN), 64 * kb, 32 * nb, 32 * nb, a.in[I_N1G] + l * D, nullptr, scr, lane); continue; } r -= I_IN;
        if (r < I_GU) { const int kb = r / 176, nb = r % 176, n0 = 32 * nb; const int row0 = n0 < DFF ? (n0 >> 7) * 256 + (n0 & 127) : ((n0 - DFF) >> 7) * 256 + 128 + ((n0 - DFF) & 127);
            tr_item(a.in[I_WGU] + (size_t)l * D * NGU, D, NGU, (bf16_t*)(a.ws + W_GU), 64 * kb, n0, row0, a.in[I_N2G] + l * D, nullptr, scr, lane); continue; } r -= I_GU;
        if (r < I_DN) { const int kb = r / 32, nb = r % 32; tr_item(a.in[I_WDN] + (size_t)l * DFF * D, DFF, D, (bf16_t*)(a.ws + W_DN), 64 * kb, 32 * nb, 32 * nb, nullptr, nullptr, scr, lane); continue; } r -= I_DN;
        if (r < 3 * I_SQ) { const int w = r / I_SQ, q = r % I_SQ, kb = q / 32, nb = q % 32;
            const float* src = a.in[w == 0 ? I_WBRA : (w == 1 ? I_WBRB : I_WOUT)] + (size_t)l * D * D; bf16_t* dst = (bf16_t*)(a.ws + (w == 0 ? W_BRA : (w == 1 ? W_BRB : W_OUT)));
            tr_item(src, D, D, dst, 64 * kb, 32 * nb, 32 * nb, nullptr, nullptr, scr, lane); continue; } r -= 3 * I_SQ;
        { const int g = r / I_PL, q = r % I_PL, kb = q / 8, nb = q % 8;
          tr_item(a.in[I_POOLW] + ((size_t)l * 4 + g) * 256 * 256, 256, 256, (bf16_t*)(a.ws + W_POOL), 64 * kb, 32 * nb, g * 256 + 32 * nb, nullptr, a.in[I_POOLS] + l * D + g * 256, scr, lane); }
    }
}

template <int NH>
__device__ __forceinline__ void load8_hist(float (&o)[8], int mode, const bf16_t* P, const bf16_t* halo, const float* st, int pm, int rho, int back, int col0) {
    const bf16_t* p = nullptr; const float* q = nullptr;
    if (mode == 0) {
        const int rr = rho - back;
        if (rr >= 0) p = P + (size_t)(pm * 256 + rr) * D + col0;
        else if (halo) p = halo + (size_t)(pm * NH + NH + rr) * D + col0;
        else if ((pm & 31) != 0) p = P + (size_t)(pm * 256 + rr) * D + col0;
        else p = P + (size_t)(ROW_M0 + (pm >> 5) * 16 + 16 + rr) * D + col0;
    } else if (mode == 1) {
        const int t = rho & 31;
        if (back <= t) p = P + (size_t)(pm * 256 + rho - back) * D + col0;
        else q = st + (size_t)((8 * (pm - 64) + (rho >> 5)) * NH + NH + t - back) * D + col0;
    } else {
        const int k = rho & 15;
        if (rho < 32 && back <= k) p = P + (size_t)(ROW_M0 + rho - back) * D + col0;
    }
    if (p) unpack8(*(const u32x4*)p, o);
    else if (q) { const f32x4 a0 = *(const f32x4*)q, a1 = *(const f32x4*)(q + 4); o[0] = a0.x; o[1] = a0.y; o[2] = a0.z; o[3] = a0.w; o[4] = a1.x; o[5] = a1.y; o[6] = a1.z; o[7] = a1.w; }
    else {
#pragma unroll
        for (int e = 0; e < 8; ++e) o[e] = 0.f;
    }
}

__device__ __forceinline__ void pool_unit(const Args& a, int l, int pm, int wave, int lane_in) {
    int lane = lane_in; asm volatile("" : "+v"(lane));
    const int mode = pm < 64 ? 0 : (pm < 66 ? 1 : 2);
    const bf16_t* PB = (const bf16_t*)(a.ws + WS_PB); bf16_t* Dd = (bf16_t*)(a.ws + WS_XBUF);
    const float* stp = a.in[I_SPOOL] + (size_t)l * 16 * 15 * D;
    const int g = wave & 3, w = 2 << g, col0 = 256 * g + 8 * (lane & 31);
    for (int it = 0; it < 64; ++it) {
        const int rho = (wave >> 2) * 128 + it * 2 + (lane >> 5);
        float s[8], x0[8];
        load8_hist<15>(x0, mode, PB, nullptr, stp, pm, rho, 0, col0);
#pragma unroll
        for (int e = 0; e < 8; ++e) s[e] = x0[e];
        for (int j = 1; j < w; ++j) { float v[8]; load8_hist<15>(v, mode, PB, nullptr, stp, pm, rho, j, col0);
#pragma unroll
            for (int e = 0; e < 8; ++e) s[e] += v[e]; }
        float cnt = (float)w;
        if (mode == 2) { const int k = (rho & 15) + 1; cnt = (float)(k < w ? k : w); }
        const float ic = 1.0f / cnt;
        float d[8];
#pragma unroll
        for (int e = 0; e < 8; ++e) d[e] = (mode == 2 && rho >= 32) ? 0.f : s[e] * ic - x0[e];
        *(u32x4*)(Dd + (size_t)(pm * 256 + rho) * D + col0) = pack8(d);
    }
}

template <bool FINAL>
__device__ __forceinline__ void lru_unit(const Args& a, int l, int pm, int h, LAS unsigned char* lds, int tid_in, int wave, int lane_in) {
    int tid = tid_in, lane = lane_in; asm volatile("" : "+v"(tid), "+v"(lane));
    const int mode = pm < 64 ? 0 : (pm < 66 ? 1 : 2);
    bf16_t* PA = (bf16_t*)(a.ws + WS_PA); const bf16_t* haloA = (const bf16_t*)(a.ws + WS_HALOA);
    const float* stc = a.in[I_SCONV] + (size_t)l * 16 * 3 * D;
    float* sumA = (float*)(a.ws + WS_SUM); float* sumH = sumA + 68 * D;
    const int fr = lane & 15, fq = lane >> 4;
    {
        const int c8 = tid & 15, col0 = h * 128 + 8 * c8;
        float cw[4][8], cb[8];
#pragma unroll
        for (int k = 0; k < 4; ++k) { const float* p = a.in[I_CONVW] + ((size_t)l * 4 + k) * D + col0; const f32x4 a0 = *(const f32x4*)p, a1 = *(const f32x4*)(p + 4);
            cw[k][0] = a0.x; cw[k][1] = a0.y; cw[k][2] = a0.z; cw[k][3] = a0.w; cw[k][4] = a1.x; cw[k][5] = a1.y; cw[k][6] = a1.z; cw[k][7] = a1.w; }
        { const float* p = a.in[I_CONVB] + (size_t)l * D + col0; const f32x4 a0 = *(const f32x4*)p, a1 = *(const f32x4*)(p + 4);
            cb[0] = a0.x; cb[1] = a0.y; cb[2] = a0.z; cb[3] = a0.w; cb[4] = a1.x; cb[5] = a1.y; cb[6] = a1.z; cb[7] = a1.w; }
        for (int it = 0; it < 8; ++it) {
            const int rho = (tid >> 4) + 32 * it;
            float y[8];
#pragma unroll
            for (int e = 0; e < 8; ++e) y[e] = cb[e];
#pragma unroll
            for (int k = 0; k < 4; ++k) { float v[8]; load8_hist<3>(v, mode, PA, haloA, stc, pm, rho, 3 - k, col0);
#pragma unroll
                for (int e = 0; e < 8; ++e) y[e] += cw[k][e] * v[e]; }
            const int swz = (rho & 3) | (((rho >> 6) & 3) << 2);
            *(LAS u32x4*)(lds + rho * 256 + 16 * (c8 ^ swz)) = pack8(y);
        }
    }
    const int chl = 16 * wave + fr, ch = h * 128 + chl;
    bf16x8 Br[4], Bi[4];
    {
        const float* wr_ = a.in[I_WR] + ((size_t)(l * 8 + h) * 128) * 128 + chl; const float* wi_ = a.in[I_WI] + ((size_t)(l * 8 + h) * 128) * 128 + chl;
#pragma unroll
        for (int ks = 0; ks < 4; ++ks) { float tr[8], ti[8];
#pragma unroll
            for (int j = 0; j < 8; ++j) { const int k = 32 * ks + 8 * fq + j; tr[j] = wr_[(size_t)k * 128]; ti[j] = wi_[(size_t)k * 128]; }
            const u32x4 pr = pack8(tr), pi = pack8(ti); Br[ks] = __builtin_bit_cast(bf16x8, pr); Bi[ks] = __builtin_bit_cast(bf16x8, pi); }
    }
    const float b_r = a.in[I_BR][l * D + ch], b_i = a.in[I_BI][l * D + ch];
    float cl; { const float lam = a.in[I_LAM][l * D + ch]; cl = -8.0f * log1pf(__expf(-lam)); }
    __syncthreads();
    f32x4 ar[16], ai_[16];
#pragma unroll
    for (int mt = 0; mt < 16; ++mt) { ar[mt] = (f32x4){0.f, 0.f, 0.f, 0.f}; ai_[mt] = (f32x4){0.f, 0.f, 0.f, 0.f}; }
    {
        const int abase = ((fr >> 2) * 64 + (fr & 3)) * 256;
#pragma unroll
        for (int mt = 0; mt < 16; ++mt)
#pragma unroll
            for (int ks = 0; ks < 4; ++ks) {
                const bf16x8 af = *(const LAS bf16x8*)(lds + abase + mt * 1024 + 16 * ((4 * ks + fq) ^ fr));
                ar[mt] = __builtin_amdgcn_mfma_f32_16x16x32_bf16(af, Br[ks], ar[mt], 0, 0, 0);
                ai_[mt] = __builtin_amdgcn_mfma_f32_16x16x32_bf16(af, Bi[ks], ai_[mt], 0, 0, 0);
            }
    }
    {
        int cbase[4];
#pragma unroll
        for (int j = 0; j < 4; ++j) cbase[j] = (64 * fq) * 256 + 16 * (((chl >> 3) ^ (fq << 2)) ^ j) + 2 * (fr & 7);
#pragma unroll
        for (int mt = 0; mt < 16; ++mt)
#pragma unroll
            for (int j = 0; j < 4; ++j) {
                const float r = fast_sigmoid(ar[mt][j] + b_r), ig = fast_sigmoid(ai_[mt][j] + b_i);
                const float la = cl * r;
                const float aa = __builtin_amdgcn_exp2f(la * 1.44269504089f);
                const float x2 = la + la;
                float om = 1.0f - aa * aa;
                if (x2 > -0.03f) om = -x2 * (1.0f + x2 * (0.5f + x2 * (0.16666667f + x2 * 0.041666668f)));
                float mult = __builtin_amdgcn_sqrtf(om > 0.f ? om : 0.f);
                if (mode == 2 && fq == 0 && j == 0 && (mt == 0 || mt == 4)) mult = 1.0f;
                const float ca = __uint_as_float((unsigned)(*(const LAS unsigned short*)(lds + cbase[j] + (4 * mt + j) * 256)) << 16);
                ar[mt][j] = aa; ai_[mt][j] = mult * ig * ca;
            }
    }
    float hs = 0.f;
    if (mode == 0) {
        float A = 1.f, H = 0.f;
#pragma unroll
        for (int mt = 0; mt < 16; ++mt)
#pragma unroll
            for (int j = 0; j < 4; ++j) { H = ar[mt][j] * H + ai_[mt][j]; A *= ar[mt][j]; }
        const float A0 = __shfl(A, fr), A1 = __shfl(A, fr + 16), A2 = __shfl(A, fr + 32), A3 = __shfl(A, fr + 48);
        const float H0 = __shfl(H, fr), H1 = __shfl(H, fr + 16), H2 = __shfl(H, fr + 32), H3 = __shfl(H, fr + 48);
        if (!FINAL) {
            if (fq == 0) { sumA[(size_t)pm * D + ch] = (A0 * A1) * (A2 * A3); sumH[(size_t)pm * D + ch] = ((H0 * A1 + H1) * A2 + H2) * A3 + H3; }
        } else {
            const int b = pm >> 5, c = pm & 31;
            float hc = sumH[(size_t)(66 + b) * D + ch];
            for (int cc = 0; cc < c; ++cc) hc = sumA[(size_t)(b * 32 + cc) * D + ch] * hc + sumH[(size_t)(b * 32 + cc) * D + ch];
            hs = hc;
            if (fq >= 1) hs = A0 * hs + H0;
            if (fq >= 2) hs = A1 * hs + H1;
            if (fq >= 3) hs = A2 * hs + H2;
        }
    }
    if (FINAL || mode == 2) {
        const float* slru = a.in[I_SLRU] + (size_t)l * 16 * D + ch;
        const int s0 = 8 * (pm - 64) + 2 * fq;
        float hcur = hs;
        if (mode == 1) hcur = slru[(size_t)s0 * D];
        float hm0 = 0.f, hm1 = 0.f;
#pragma unroll
        for (int mt = 0; mt < 16; ++mt) {
            if (mode == 1 && mt == 8) hcur = slru[(size_t)(s0 + 1) * D];
            if (mode == 2 && mt == 4) hcur = 0.f;
#pragma unroll
            for (int j = 0; j < 4; ++j) {
                hcur = ar[mt][j] * hcur + ai_[mt][j];
                if (FINAL) *(LAS unsigned short*)(lds + 65536 + (64 * fq + 4 * mt + j) * 256 + 2 * chl) = (unsigned short)(cvt_pk_bf16(hcur, 0.f) & 0xffffu);
            }
            if (mt == 3) hm0 = hcur;
            if (mt == 7) hm1 = hcur;
        }
        if (!FINAL) { if (fq == 0) { sumH[(size_t)66 * D + ch] = hm0; sumH[(size_t)67 * D + ch] = hm1; } }
        else {
            if (mode == 0 && (pm & 31) == 31 && fq == 3) a.out[O_LRU_P + (size_t)(l * 2 + (pm >> 5)) * D + ch] = hcur;
            if (mode == 1) { a.out[O_LRU_S + (size_t)(l * 16 + s0) * D + ch] = hm1; a.out[O_LRU_S + (size_t)(l * 16 + s0 + 1) * D + ch] = hcur; }
        }
    }
    __syncthreads();
    if (FINAL) {
#pragma unroll
        for (int it = 0; it < 8; ++it) { const int idx = tid + 512 * it, rho = idx >> 4, c8 = idx & 15;
            *(u32x4*)(PA + (size_t)(pm * 256 + rho) * D + h * 128 + 8 * c8) = *(const LAS u32x4*)(lds + 65536 + rho * 256 + 16 * c8); }
        __syncthreads();
    }
}

__device__ __forceinline__ void phase_final(const Args& a, int gw, int NGW, int lane) {
    const float* ssq = (const float*)(a.ws + WS_SSQ) + 4 * MP;
    for (int r = gw; r < ROW_M0; r += NGW) {
        const float rs = __builtin_amdgcn_rsqf(ssq[r] * (1.0f / D) + EPS);
        f32x4* xr = (f32x4*)(a.out + (size_t)r * D);
#pragma unroll
        for (int j = 0; j < 4; ++j) { const f32x4 gg = ((const f32x4*)a.in[I_FING])[lane + 64 * j]; f32x4 v = xr[lane + 64 * j]; v = v * rs * gg; xr[lane + 64 * j] = v; }
    }
}

constexpr int N_PHASES = 20;
#ifndef PH_MASK
#define PH_MASK 0xFFFF
#endif
#define PT(t) ((PH_MASK >> (t)) & 1)
__global__ void __launch_bounds__(NWAVES * 64, 2) fwd_kernel(Args args) {
    extern __shared__ __attribute__((aligned(16))) unsigned char lds_raw[];
    LAS unsigned char* lds = (LAS unsigned char*)lds_raw;
    {
        const int tid0 = threadIdx.x;
        for (int u = tid0; u < (LDS_BYTES - LDSCTL_OFF) / 4; u += NWAVES * 64) ((LAS unsigned*)(lds + LDSCTL_OFF))[u] = 0u;
        __syncthreads();
    }
    XcdBarrier bar; bar.bar = (unsigned*)(args.ws + WS_CTL) + CW_BAR; bar.x = 0; bar.st = (volatile LAS unsigned*)(lds + MISC_OFF) + 8;
    if (!MK_PER_PHASE) bar = xcd_barrier_post(bar.bar, bar.st);
    const int lo = args.ph_lo, hi = args.ph_hi;
#pragma unroll 1
    for (int ph = lo; ph < hi; ++ph) {
        int tid = threadIdx.x; asm volatile("" : "+v"(tid));
        const int lane = tid & 63, wave = __builtin_amdgcn_readfirstlane(tid >> 6);
        const int G = gridDim.x, bx = blockIdx.x;
        const int vcu = (G % 8 == 0) ? (bx % 8) * (G / 8) + bx / 8 : bx;
        const int gw = vcu * NWAVES + wave, NGW = G * NWAVES;
        float* ssq = (float*)(args.ws + WS_SSQ);
        bf16_t* XBUF = (bf16_t*)(args.ws + WS_XBUF);
        bf16_t* PA = (bf16_t*)(args.ws + WS_PA);
        const int l = ph >= 10 ? 1 : 0;
        const int pt = ph == 0 ? 0 : (ph == 19 ? 10 : ph - 9 * l);
        bool seam = true;
        switch (pt) {
        case 0: if (PT(0)) { phase_init(args, gw, NGW, lane); seam = false; } break;
        case 1: if (PT(1)) { phase_weights(args, l, lds, gw, NGW, wave, lane); } break;
        case 2: if (PT(2)) {
            pg8::Gemm g{XBUF, (const bf16_t*)(args.ws + W_IN), MP, NIN, D, D, 0}; pg8::StaticOrder S; S.init(MP, NIN, G, bx);
            EpiIn E{PA, (bf16_t*)(args.ws + WS_HALOA), ssq + (size_t)(2 * l) * MP, args.out, l};
            pg8::gemm_phase(lds, g, S, E); } break;
        case 3: if (PT(3)) {
            constexpr int NL = 65 * 8;
            for (int u = vcu; u < NL + NTILE; u += G) {
                if (u < NL) { const int t = u >> 3; lru_unit<false>(args, l, t < 64 ? t : 66, u & 7, lds, tid, wave, lane); }
                else pool_unit(args, l, u - NL, wave, lane);
            } } break;
        case 4: if (PT(4)) {
            for (int u = vcu; u < NTILE * 8; u += G) lru_unit<true>(args, l, u >> 3, u & 7, lds, tid, wave, lane);
            pg8::Gemm g{XBUF, (const bf16_t*)(args.ws + W_POOL), MP, D, 256, D, 256}; pg8::StaticOrder S; S.init(MP, D, G, bx);
            EpiStore E{(bf16_t*)(args.ws + WS_YB), D};
            pg8::gemm_phase(lds, g, S, E); } break;
        case 5: if (PT(5)) {
            pg8::Gemm g{PA, (const bf16_t*)(args.ws + W_BRA), MP, D, D, D, 0}; pg8::StaticOrder S; S.init(MP, D, G, bx);
            EpiGate<false> E{(const bf16_t*)(args.ws + WS_PGA), nullptr, XBUF};
            pg8::gemm_phase(lds, g, S, E); } break;
        case 6: if (PT(6)) {
            pg8::Gemm g{(const bf16_t*)(args.ws + WS_YB), (const bf16_t*)(args.ws + W_BRB), MP, D, D, D, 0}; pg8::StaticOrder S; S.init(MP, D, G, bx);
            EpiGate<true> E{(const bf16_t*)(args.ws + WS_PGB), XBUF, PA};
            pg8::gemm_phase(lds, g, S, E); } break;
        case 7: if (PT(7)) {
            pg8::Gemm g{PA, (const bf16_t*)(args.ws + W_OUT), MP, D, D, D, 0}; pg8::StaticOrder S; S.init(MP, D, G, bx);
            EpiRes E{args.out, (float*)(args.ws + WS_XMETA), XBUF, ssq + (size_t)(2 * l + 1) * MP};
            pg8::gemm_phase(lds, g, S, E); } break;
        case 8: if (PT(8)) {
            pg8::Gemm g{XBUF, (const bf16_t*)(args.ws + W_GU), MP, NGU, D, D, 0}; pg8::StaticOrder S; S.init(MP, NGU, G, bx);
            EpiGU E{PA, ssq + (size_t)(2 * l + 1) * MP};
            pg8::gemm_phase(lds, g, S, E); } break;
        case 9: if (PT(9)) {
            pg8::Gemm g{PA, (const bf16_t*)(args.ws + W_DN), MP, D, DFF, DFF, 0}; pg8::StaticOrder S; S.init(MP, D, G, bx);
            EpiRes E{args.out, (float*)(args.ws + WS_XMETA), XBUF, ssq + (size_t)(2 * l + 2) * MP};
            pg8::gemm_phase(lds, g, S, E); } break;
        default: if (PT(10)) { phase_final(args, gw, NGW, lane); } break;
        }
        __syncthreads();
        if (seam && ph + 1 < hi) xcd_barrier(bar);
    }
}

extern "C" void kernel_launch(void* const* d_in, const int* in_sizes, int n_in, void* d_out, int out_size, void* d_ws, size_t ws_size, hipStream_t stream) {
    static int grid = 0;
    if (grid == 0) {
        if (n_in != 24 || (size_t)out_size != O_END || ws_size < WS_END) { fprintf(stderr, "kernel_launch: unexpected shapes (n_in %d out %d ws %zu)\n", n_in, out_size, ws_size); grid = -1; return; }
        int dev = 0, cus = 0, per_cu = 0;
        if (hipGetDevice(&dev) != hipSuccess || hipDeviceGetAttribute(&cus, hipDeviceAttributeMultiprocessorCount, dev) != hipSuccess) { grid = -1; return; }
        if (hipFuncSetAttribute((const void*)fwd_kernel, hipFuncAttributeMaxDynamicSharedMemorySize, LDS_BYTES) != hipSuccess) { fprintf(stderr, "kernel_launch: hipFuncSetAttribute failed\n"); grid = -1; return; }
        if (hipOccupancyMaxActiveBlocksPerMultiprocessor(&per_cu, (const void*)fwd_kernel, NWAVES * 64, LDS_BYTES) != hipSuccess || per_cu < 1) { fprintf(stderr, "kernel_launch: occupancy query says %d\n", per_cu); (void)hipGetLastError(); grid = -1; return; }
        grid = cus;
    }
    if (grid < 0) return;
    (void)hipMemsetAsync((char*)d_ws + WS_CTL, 0, CTL_ZERO_BYTES, stream);
    Args a{};
    for (int i = 0; i < 24; ++i) a.in[i] = (const float*)d_in[i];
    a.out = (float*)d_out; a.ws = (unsigned char*)d_ws;
#if MK_PER_PHASE
    for (int p = 0; p < N_PHASES; ++p) { a.ph_lo = p; a.ph_hi = p + 1; hipLaunchKernelGGL(fwd_kernel, dim3(grid), dim3(NWAVES * 64), LDS_BYTES, stream, a); }
#else
    a.ph_lo = 0; a.ph_hi = N_PHASES;
    void* kargs[] = {&a};
    hipError_t e = hipLaunchCooperativeKernel((const void*)fwd_kernel, dim3(grid), dim3(NWAVES * 64), kargs, LDS_BYTES, stream);
    if (e != hipSuccess) fprintf(stderr, "kernel_launch: cooperative launch failed: %s (grid %d)\n", hipGetErrorString(e), grid);
#endif
}
```

```cpp
#include <hip/hip_runtime.h>
#include <cstdio>
#include <cstdint>

#ifndef MK_PER_PHASE
#define MK_PER_PHASE 0
#endif

#define GAS __attribute__((address_space(1)))
#define LAS __attribute__((address_space(3)))

typedef unsigned short bf16_t;
typedef short bf16x8 __attribute__((ext_vector_type(8)));
typedef float f32x4 __attribute__((ext_vector_type(4)));
typedef float f32x2 __attribute__((ext_vector_type(2)));
typedef unsigned u32x4 __attribute__((ext_vector_type(4)));
typedef unsigned u32x2 __attribute__((ext_vector_type(2)));

constexpr int D = 1024, DFF = 2816, NGU = 2 * DFF, NIN = 4096;
constexpr int SEQ = 8192, DEC_B = 16, DEC_T = 32, DEPTH = 2;
constexpr int ROWS_P = 2 * SEQ;
constexpr int ROWS_S = DEC_B * DEC_T;
constexpr int ROW_M0 = ROWS_P + ROWS_S;
constexpr int MP = 17152, NTILE = 67;
constexpr float EPS = 1e-6f;

constexpr size_t O_YS = (size_t)ROWS_P * D;
constexpr size_t O_CONV_P = O_YS + (size_t)ROWS_S * D;
constexpr size_t O_LRU_P = O_CONV_P + (size_t)DEPTH * 2 * 3 * D;
constexpr size_t O_POOL_P = O_LRU_P + (size_t)DEPTH * 2 * D;
constexpr size_t O_CONV_S = O_POOL_P + (size_t)DEPTH * 2 * 15 * D;
constexpr size_t O_LRU_S = O_CONV_S + (size_t)DEPTH * 16 * 3 * D;
constexpr size_t O_POOL_S = O_LRU_S + (size_t)DEPTH * 16 * D;
constexpr size_t O_END = O_POOL_S + (size_t)DEPTH * 16 * 15 * D;

constexpr size_t MiB = 1u << 20;
constexpr size_t SZ_ACT = (size_t)MP * D * 2;
constexpr size_t WS_CTL = 0, CTL_ZERO_BYTES = 1 * MiB;
constexpr size_t WS_SSQ = 64 * 1024;
constexpr size_t WS_SUM = 1 * MiB;
constexpr size_t WS_HALOA = 2 * MiB;
constexpr size_t WS_XMETA = 3 * MiB;
constexpr size_t WS_W = 4 * MiB;
constexpr size_t W_IN = WS_W, W_GU = W_IN + 8 * MiB, W_DN = W_GU + 11 * MiB, W_BRA = W_DN + 5632 * 1024, W_BRB = W_BRA + 2 * MiB, W_OUT = W_BRB + 2 * MiB, W_POOL = W_OUT + 2 * MiB;
constexpr size_t WS_XBUF = 36 * MiB;
constexpr size_t WS_PA = 70 * MiB, WS_PB = WS_PA + SZ_ACT, WS_PGA = WS_PB + SZ_ACT, WS_PGB = WS_PGA + SZ_ACT;
constexpr size_t WS_YB = WS_PGB + SZ_ACT;
constexpr size_t WS_END = WS_YB + SZ_ACT;
static_assert(W_POOL + 512 * 1024 <= WS_XBUF && WS_XBUF + SZ_ACT <= WS_PA && WS_END <= 256 * MiB, "d_ws map");
static_assert((size_t)MP * DFF * 2 <= 4 * SZ_ACT, "H overlay");
constexpr int CW_TMO = 0, CW_BAR = 4096;

constexpr int RING_BYTES = 131072, LDSCTL_OFF = RING_BYTES, MISC_OFF = LDSCTL_OFF + 320, LDS_BYTES = 147456;
constexpr int NWAVES = 8;

__device__ __forceinline__ unsigned cvt_pk_bf16(float lo, float hi) { unsigned r; asm volatile("v_cvt_pk_bf16_f32 %0, %1, %2" : "=v"(r) : "v"(lo), "v"(hi)); return r; }
__device__ __forceinline__ float bf_lo(unsigned w) { return __uint_as_float(w << 16); }
__device__ __forceinline__ float bf_hi(unsigned w) { return __uint_as_float(w & 0xffff0000u); }
__device__ __forceinline__ float fast_sigmoid(float v) { return __builtin_amdgcn_rcpf(1.0f + __builtin_amdgcn_exp2f(v * -1.44269504089f)); }
__device__ __forceinline__ float wave_sum(float v) {
#pragma unroll
    for (int o = 1; o < 64; o <<= 1) v += __shfl_xor(v, o);
    return v;
}
__device__ __forceinline__ void unpack8(const u32x4 w, float (&o)[8]) {
    o[0] = bf_lo(w.x); o[1] = bf_hi(w.x); o[2] = bf_lo(w.y); o[3] = bf_hi(w.y); o[4] = bf_lo(w.z); o[5] = bf_hi(w.z); o[6] = bf_lo(w.w); o[7] = bf_hi(w.w);
}
__device__ __forceinline__ u32x4 pack8(const float (&v)[8]) {
    u32x4 w; w.x = cvt_pk_bf16(v[0], v[1]); w.y = cvt_pk_bf16(v[2], v[3]); w.z = cvt_pk_bf16(v[4], v[5]); w.w = cvt_pk_bf16(v[6], v[7]); return w;
}
#define LDS_WAIT() asm volatile("s_waitcnt lgkmcnt(0)" ::: "memory")
#define VM_WAIT() asm volatile("s_waitcnt vmcnt(0)" ::: "memory")

namespace pg8 {
constexpr int BM = 256, BK = 64, HALF = 128, HTB = HALF * BK * 2, STAGE_BYTES = 8 * HTB, NXCD = 8, WGM = 8;
__host__ __device__ __forceinline__ int lds_byte(int r, int c) { const int st = (r >> 4) * 2 + (c >> 5), rr = r & 15, cc = c & 31, ob = rr * 64 + cc * 2; return st * 1024 + (ob ^ (((ob >> 9) & 1) << 5)); }
__host__ __device__ __forceinline__ void stage_rc(int b, int& R, int& C) { const int st = b / 1024, sb = b % 1024, swz = sb ^ (((sb >> 9) & 1) << 5); R = (st >> 1) * 16 + swz / 64; C = (st & 1) * 32 + (swz % 64) / 2; }
__host__ __device__ __forceinline__ int perm32(int rho) { const int n = rho >> 4, i = rho & 15; return 8 * (i >> 2) + 4 * n + (i & 3); }

struct Unit { int pm, pn; };
struct Gemm { const bf16_t* A; const bf16_t* Bt; int M, N, K, lda, a_pn_off; };

struct StaticOrder {
    int nM, nN, nwg, G, c;
    __device__ void init(int M, int N, int G_, int c_) { nM = M / BM; nN = N / BM; nwg = nM * nN; G = G_; c = c_; }
    __device__ bool next(int i, Unit& u) const {
        const long L = (long)i * G + c; if (L >= nwg) return false;
        int wgid = (int)L; { const int q = nwg / NXCD, r = nwg % NXCD, xcd = wgid % NXCD, off = wgid / NXCD; wgid = (xcd < r ? xcd * (q + 1) : r * (q + 1) + (xcd - r) * q) + off; }
        const int nig = WGM * nN, gid = wgid / nig, fm = gid * WGM, gsz = (nM - fm) < WGM ? (nM - fm) : WGM;
        u.pm = fm + ((wgid % nig) % gsz); u.pn = (wgid % nig) / gsz; return true;
    }
};

template <class Epi>
__device__ __forceinline__ void gemm_phase(LAS unsigned char* lds, const Gemm g, const StaticOrder& S, const Epi& E) {
    int tid_ = threadIdx.x; asm volatile("" : "+v"(tid_));
    const int tid = tid_, wid = __builtin_amdgcn_readfirstlane(tid >> 6), lane = tid & 63, wr = wid >> 2, wc = wid & 3, fr = lane & 15, fq = lane >> 4;
    const int K = g.K, nt = K / BK, lda = g.lda;
    unsigned voffA[2], voffB[2];
#pragma unroll
    for (int i = 0; i < 2; ++i) { int R, C; stage_rc(tid * 16 + i * 8192, R, C); const int Rb = (R & ~31) + perm32(R & 31);
        voffA[i] = (unsigned)(R * lda + C) * 2u; voffB[i] = (unsigned)(Rb * K + C) * 2u; }
    const size_t kstep = (size_t)(BK * 2);
    const size_t hstepA = (size_t)HALF * lda * 2, tstepA = 2 * hstepA;
    const size_t hstepB = (size_t)HALF * K * 2, tstepB = 2 * hstepB;
    const size_t pnoffA = (size_t)g.a_pn_off * 2;
    const unsigned ldsw = (unsigned)wid * 1024u;
    const int aoff = lds_byte(wr * 64 + fr, fq * 8), boff = lds_byte(wc * 32 + fr, fq * 8);
#define PG8_SA(b, h) (((b) * 2 + (h)) * HTB)
#define PG8_SB(b, h) ((4 + (b) * 2 + (h)) * HTB)
#define PG8_STAGE(bufoff, gbase, voff) do { _Pragma("unroll") for (int _i = 0; _i < 2; ++_i) \
        __builtin_amdgcn_global_load_lds((const unsigned*)((const char*)(gbase) + (voff)[_i]), (LAS unsigned*)(lds + (bufoff) + ldsw + _i * 8192), 16, 0, 0); } while (0)
#define PG8_LDA(dst, b, h) do { _Pragma("unroll") for (int m = 0; m < 4; ++m) _Pragma("unroll") for (int k = 0; k < 2; ++k) dst[m][k] = *(const LAS bf16x8*)(lds + PG8_SA(b, h) + aoff + m * 2048 + k * 1024); } while (0)
#define PG8_LDB(dst, b, h) do { _Pragma("unroll") for (int n = 0; n < 2; ++n) _Pragma("unroll") for (int k = 0; k < 2; ++k) dst[n][k] = *(const LAS bf16x8*)(lds + PG8_SB(b, h) + boff + n * 2048 + k * 1024); } while (0)
#define PG8_MMA(ai, bj, At, Bt) do { __builtin_amdgcn_s_setprio(1); _Pragma("unroll") for (int m = 0; m < 4; ++m) _Pragma("unroll") for (int n = 0; n < 2; ++n) _Pragma("unroll") for (int k = 0; k < 2; ++k) \
        acc[ai][bj][m][n] = __builtin_amdgcn_mfma_f32_16x16x32_bf16(Bt[n][k], At[m][k], acc[ai][bj][m][n], 0, 0, 0); __builtin_amdgcn_s_setprio(0); } while (0)
#define PG8_WAIT_V(n) asm volatile("s_waitcnt vmcnt(" #n ")" ::: "memory")
#define PG8_WAIT_L(n) asm volatile("s_waitcnt lgkmcnt(" #n ")" ::: "memory")
#define PG8_BAR __builtin_amdgcn_s_barrier()
#define PG8_SCHED __builtin_amdgcn_sched_barrier(0)
    Unit cur, nxt; int ui = 0;
    if (!S.next(0, cur)) return;
    f32x4 acc[2][2][4][2];
#pragma unroll
    for (int a = 0; a < 2; ++a)
#pragma unroll
        for (int b = 0; b < 2; ++b)
#pragma unroll
            for (int m = 0; m < 4; ++m)
#pragma unroll
                for (int n = 0; n < 2; ++n) acc[a][b][m][n] = (f32x4){0.f, 0.f, 0.f, 0.f};
    bf16x8 At[4][2], B0[2][2], B1[2][2];
    const char* cA = (const char*)g.A + (size_t)cur.pm * tstepA + (size_t)cur.pn * pnoffA; const char* cB = (const char*)g.Bt + (size_t)cur.pn * tstepB;
    PG8_STAGE(PG8_SB(0, 0), cB, voffB); PG8_STAGE(PG8_SB(0, 1), cB + hstepB, voffB); PG8_STAGE(PG8_SA(0, 0), cA, voffA); PG8_STAGE(PG8_SA(0, 1), cA + hstepA, voffA);
    if (wr == 1) PG8_BAR;
    PG8_WAIT_V(2); PG8_BAR;
    PG8_STAGE(PG8_SB(1, 0), cB + kstep, voffB); PG8_STAGE(PG8_SA(1, 0), cA + kstep, voffA); PG8_STAGE(PG8_SB(1, 1), cB + hstepB + kstep, voffB);
    PG8_WAIT_V(6); PG8_BAR;
    for (;;) {
        const bool has_next = S.next(ui + 1, nxt);
        const char* nA = has_next ? (const char*)g.A + (size_t)nxt.pm * tstepA + (size_t)nxt.pn * pnoffA : cA; const char* nB = has_next ? (const char*)g.Bt + (size_t)nxt.pn * tstepB : cB;
#pragma unroll 1
        for (int t = 0; t < nt; t += 2) {
            const bool last = (t == nt - 2);
            const char* a1 = cA + (size_t)(t + 1) * kstep;
            const char* a2 = last ? nA : cA + (size_t)(t + 2) * kstep; const char* b2 = last ? nB : cB + (size_t)(t + 2) * kstep;
            const char* a3 = a2 + kstep; const char* b3 = b2 + kstep;
            PG8_LDB(B0, 0, 0); PG8_LDB(B1, 0, 1); PG8_SCHED; PG8_LDA(At, 0, 0); PG8_STAGE(PG8_SA(1, 1), a1 + hstepA, voffA);
            PG8_WAIT_V(8); PG8_WAIT_L(0); PG8_BAR; PG8_MMA(0, 0, At, B0); PG8_MMA(0, 1, At, B1); PG8_BAR; PG8_SCHED;
            PG8_LDA(At, 0, 1); PG8_STAGE(PG8_SB(0, 0), b2, voffB); PG8_STAGE(PG8_SB(0, 1), b2 + hstepB, voffB); PG8_STAGE(PG8_SA(0, 0), a2, voffA);
            PG8_WAIT_V(8); PG8_WAIT_L(0); PG8_BAR; PG8_MMA(1, 0, At, B0); PG8_MMA(1, 1, At, B1); PG8_BAR; PG8_SCHED;
            PG8_LDB(B0, 1, 0); PG8_LDB(B1, 1, 1); PG8_SCHED; PG8_LDA(At, 1, 0); PG8_STAGE(PG8_SA(0, 1), a2 + hstepA, voffA);
            PG8_WAIT_V(8); PG8_WAIT_L(0); PG8_BAR; PG8_MMA(0, 0, At, B0); PG8_MMA(0, 1, At, B1); PG8_BAR; PG8_SCHED;
            PG8_LDA(At, 1, 1); PG8_STAGE(PG8_SB(1, 0), b3, voffB); PG8_STAGE(PG8_SB(1, 1), b3 + hstepB, voffB); PG8_STAGE(PG8_SA(1, 0), a3, voffA);
            PG8_WAIT_V(8); PG8_WAIT_L(0); PG8_BAR; PG8_MMA(1, 0, At, B0); PG8_MMA(1, 1, At, B1); PG8_BAR; PG8_SCHED;
        }
        if (wr == 0) PG8_BAR;
        { int fr_e = fr, fq_e = fq; asm volatile("" : "+v"(fr_e), "+v"(fq_e)); E(acc, cur, wr, wc, fr_e, fq_e); }
        if (!has_next) break;
#pragma unroll
        for (int a = 0; a < 2; ++a)
#pragma unroll
            for (int b = 0; b < 2; ++b)
#pragma unroll
                for (int m = 0; m < 4; ++m)
#pragma unroll
                    for (int n = 0; n < 2; ++n) acc[a][b][m][n] = (f32x4){0.f, 0.f, 0.f, 0.f};
        cur = nxt; cA = nA; cB = nB; ++ui;
        if (wr == 1) PG8_BAR;
    }
    PG8_WAIT_V(0);
    PG8_BAR;
#undef PG8_SA
#undef PG8_SB
#undef PG8_STAGE
#undef PG8_LDA
#undef PG8_LDB
#undef PG8_MMA
#undef PG8_WAIT_V
#undef PG8_WAIT_L
#undef PG8_BAR
#undef PG8_SCHED
}
}

#define EPI_ROWS_BEGIN _Pragma("unroll") for (int ai = 0; ai < 2; ++ai) _Pragma("unroll") for (int m = 0; m < 4; ++m) { const int lr = ai * 128 + wr * 64 + m * 16 + fr; const int row = u.pm * 256 + lr; (void)row;
#define EPI_ROWS_END asm volatile("" ::: "memory"); }

struct EpiIn {
    bf16_t* P;
    bf16_t* haloA;
    const float* ssq;
    float* out;
    int layer;
    __device__ __forceinline__ void operator()(const f32x4 (&acc)[2][2][4][2], const pg8::Unit& u, int wr, int wc, int fr, int fq) const {
        const int t = u.pn >> 2;
        bf16_t* base = P + (size_t)t * (SZ_ACT / 2);
        const int lc0 = (u.pn & 3) * 256 + wc * 32 + 8 * fq;
        const bool special = (t < 2);
        EPI_ROWS_BEGIN
            const float rs = __builtin_amdgcn_rsqf(ssq[row] * (1.0f / D) + EPS);
#pragma unroll
            for (int bj = 0; bj < 2; ++bj) {
                float v[8];
#pragma unroll
                for (int n = 0; n < 2; ++n)
#pragma unroll
                    for (int e = 0; e < 4; ++e) { float x = acc[ai][bj][m][n][e] * rs; if (t >= 2) x = fast_sigmoid(x); v[n * 4 + e] = x; }
                const u32x4 w = pack8(v);
                const int lc = lc0 + bj * 128;
                *(u32x4*)(base + (size_t)row * D + lc) = w;
                if (special) {
                    if (t == 0) {
                        if (u.pm < 64) { if ((u.pm & 31) != 31 && lr >= 253) *(u32x4*)(haloA + ((size_t)(u.pm + 1) * 3 + (lr - 253)) * D + lc) = w; }
                        else if (u.pm == 66) { if (lr >= 13 && lr < 16) *(u32x4*)(haloA + ((size_t)0 * 3 + (lr - 13)) * D + lc) = w;
                                               if (lr >= 29 && lr < 32) *(u32x4*)(haloA + ((size_t)32 * 3 + (lr - 29)) * D + lc) = w; }
                        float* o = nullptr;
                        if (u.pm < 64) { if ((u.pm & 31) == 31 && lr >= 253) o = out + O_CONV_P + ((size_t)(layer * 2 + (u.pm >> 5)) * 3 + (lr - 253)) * D + lc; }
                        else if (u.pm < 66) { const int ts = lr & 31; if (ts >= 29) o = out + O_CONV_S + ((size_t)(layer * 16 + 8 * (u.pm - 64) + (lr >> 5)) * 3 + (ts - 29)) * D + lc; }
                        if (o) { *(f32x4*)o = (f32x4){v[0], v[1], v[2], v[3]}; *(f32x4*)(o + 4) = (f32x4){v[4], v[5], v[6], v[7]}; }
                    } else {
                        float* o = nullptr;
                        if (u.pm < 64) { if ((u.pm & 31) == 31 && lr >= 241) o = out + O_POOL_P + ((size_t)(layer * 2 + (u.pm >> 5)) * 15 + (lr - 241)) * D + lc; }
                        else if (u.pm < 66) { const int ts = lr & 31; if (ts >= 17) o = out + O_POOL_S + ((size_t)(layer * 16 + 8 * (u.pm - 64) + (lr >> 5)) * 15 + (ts - 17)) * D + lc; }
                        if (o) { *(f32x4*)o = (f32x4){v[0], v[1], v[2], v[3]}; *(f32x4*)(o + 4) = (f32x4){v[4], v[5], v[6], v[7]}; }
                    }
                }
            }
        EPI_ROWS_END
    }
};

struct EpiStore {
    bf16_t* O; int ldc;
    __device__ __forceinline__ void operator()(const f32x4 (&acc)[2][2][4][2], const pg8::Unit& u, int wr, int wc, int fr, int fq) const {
        const int c0 = u.pn * 256 + wc * 32 + 8 * fq;
        EPI_ROWS_BEGIN
#pragma unroll
            for (int bj = 0; bj < 2; ++bj) {
                float v[8];
#pragma unroll
                for (int n = 0; n < 2; ++n)
#pragma unroll
                    for (int e = 0; e < 4; ++e) v[n * 4 + e] = acc[ai][bj][m][n][e];
                *(u32x4*)(O + (size_t)row * ldc + c0 + bj * 128) = pack8(v);
            }
        EPI_ROWS_END
    }
};

template <bool SECOND> struct EpiGate {
    const bf16_t* gate; const bf16_t* t1; bf16_t* O;
    __device__ __forceinline__ void operator()(const f32x4 (&acc)[2][2][4][2], const pg8::Unit& u, int wr, int wc, int fr, int fq) const {
        const int c0 = u.pn * 256 + wc * 32 + 8 * fq;
        EPI_ROWS_BEGIN
#pragma unroll
            for (int bj = 0; bj < 2; ++bj) {
                const size_t off = (size_t)row * D + c0 + bj * 128;
                float gv[8], v[8]; unpack8(*(const u32x4*)(gate + off), gv);
                if (SECOND) { float tv[8]; unpack8(*(const u32x4*)(t1 + off), tv);
#pragma unroll
                    for (int n = 0; n < 2; ++n)
#pragma unroll
                        for (int e = 0; e < 4; ++e) v[n * 4 + e] = tv[n * 4 + e] + gv[n * 4 + e] * acc[ai][bj][m][n][e];
                } else {
#pragma unroll
                    for (int n = 0; n < 2; ++n)
#pragma unroll
                        for (int e = 0; e < 4; ++e) v[n * 4 + e] = gv[n * 4 + e] * acc[ai][bj][m][n][e];
                }
                *(u32x4*)(O + off) = pack8(v);
            }
        EPI_ROWS_END
    }
};

struct EpiRes {
    float* xmain; float* xmeta; bf16_t* xb; float* ssq_next;
    __device__ __forceinline__ void operator()(const f32x4 (&acc)[2][2][4][2], const pg8::Unit& u, int wr, int wc, int fr, int fq) const {
        const int c0 = u.pn * 256 + wc * 32 + 8 * fq;
        float* xbase = (u.pm < 66) ? xmain + (size_t)u.pm * 256 * D : xmeta;
        EPI_ROWS_BEGIN
            float s = 0.f;
#pragma unroll
            for (int bj = 0; bj < 2; ++bj) {
                float* xp = xbase + (size_t)lr * D + c0 + bj * 128;
                const f32x4 x0 = *(const f32x4*)xp, x1 = *(const f32x4*)(xp + 4);
                float v[8];
#pragma unroll
                for (int e = 0; e < 4; ++e) { v[e] = x0[e] + acc[ai][bj][m][0][e]; v[4 + e] = x1[e] + acc[ai][bj][m][1][e]; }
#pragma unroll
                for (int e = 0; e < 8; ++e) s += v[e] * v[e];
                *(f32x4*)xp = (f32x4){v[0], v[1], v[2], v[3]}; *(f32x4*)(xp + 4) = (f32x4){v[4], v[5], v[6], v[7]};
                *(u32x4*)(xb + (size_t)row * D + c0 + bj * 128) = pack8(v);
            }
            s += __shfl_xor(s, 16); s += __shfl_xor(s, 32);
            if (fq == 0) atomicAdd(ssq_next + row, s);
        EPI_ROWS_END
    }
};

struct EpiGU {
    bf16_t* H; const float* ssq;
    __device__ __forceinline__ void operator()(const f32x4 (&acc)[2][2][4][2], const pg8::Unit& u, int wr, int wc, int fr, int fq) const {
        const int c0 = u.pn * 128 + wc * 32 + 8 * fq;
        EPI_ROWS_BEGIN
            const float rs = __builtin_amdgcn_rsqf(ssq[row] * (1.0f / D) + EPS);
            float v[8];
#pragma unroll
            for (int n = 0; n < 2; ++n)
#pragma unroll
                for (int e = 0; e < 4; ++e) { const float gg = acc[ai][0][m][n][e] * rs, uu = acc[ai][1][m][n][e] * rs; v[n * 4 + e] = gg * fast_sigmoid(gg) * uu; }
            *(u32x4*)(H + (size_t)row * DFF + c0) = pack8(v);
        EPI_ROWS_END
    }
};

#define XB_TMO      128
#define XB_XCNT(j)  (256  + 64 * (j))
#define XB_XSUB(j)  (1280 + 64 * (j))
#define XB_XGEN(j)  (2304 + 64 * (j))
#define XB_TOP      3328
#define XB_TOPGEN   3392
#define XCD_BAR_WORDS 3456
#define XB_SPIN_CAP (1u << 20)
__device__ __forceinline__ unsigned xb_ld(unsigned* p)              { return __hip_atomic_load(p, __ATOMIC_RELAXED, __HIP_MEMORY_SCOPE_AGENT); }
__device__ __forceinline__ unsigned xb_add(unsigned* p, unsigned v) { return __hip_atomic_fetch_add(p, v, __ATOMIC_RELAXED, __HIP_MEMORY_SCOPE_AGENT); }
__device__ __forceinline__ unsigned xb_xcc_id() { return (unsigned)__builtin_amdgcn_s_getreg((3 << 11) | 20) & 0xFu; }
#define XB_SPIN(cond, bar) do { unsigned _sp = 0; while (cond) { __builtin_amdgcn_s_sleep(1); \
    if ((++_sp & 255u) == 0u) { if (xb_ld(&(bar)[XB_TMO])) break; if (_sp > XB_SPIN_CAP) { atomicAdd(&(bar)[XB_TMO], 1u); break; } } } } while (0)
struct XcdBarrier { unsigned* bar; unsigned x; volatile LAS unsigned* st; };
__device__ __forceinline__ XcdBarrier xcd_barrier_post(unsigned* bar, volatile LAS unsigned* st) {
    XcdBarrier b; b.bar = bar; b.x = xb_xcc_id(); b.st = st;
    if (threadIdx.x == 0) (void)xb_add(&bar[XB_XCNT(b.x)], 1u);
    return b;
}
__device__ __forceinline__ void xcd_barrier_complete(unsigned* bar, unsigned x, unsigned& nloc, unsigned& nx) {
    const unsigned G = gridDim.x * gridDim.y * gridDim.z;
    unsigned sum, cnt, mine, sp = 0u;
    for (;;) {
        sum = 0u; cnt = 0u; mine = 0u;
#pragma unroll
        for (unsigned j = 0; j < 16; ++j) { const unsigned c = xb_ld(&bar[XB_XCNT(j)]); sum += c; cnt += (c > 0u) ? 1u : 0u; mine = (j == x) ? c : mine; }
        if (sum == G) break;
        __builtin_amdgcn_s_sleep(1);
        if ((++sp & 255u) == 0u) { if (xb_ld(&bar[XB_TMO])) break; if (sp > XB_SPIN_CAP) { atomicAdd(&bar[XB_TMO], 1u); break; } }
    }
    nloc = mine > 0u ? mine : 1u; nx = cnt > 0u ? cnt : 1u;
}
__device__ __forceinline__ void xcd_barrier(const XcdBarrier& b) {
    asm volatile("s_waitcnt vmcnt(0)" ::: "memory");
    __syncthreads();
    if (threadIdx.x == 0) {
        unsigned* bar = b.bar;
        __builtin_amdgcn_s_waitcnt(0);
        unsigned nloc = b.st[0], nx = b.st[1];
        if (nloc == 0u) { xcd_barrier_complete(bar, b.x, nloc, nx); b.st[0] = nloc; b.st[1] = nx; }
        const unsigned old = xb_add(&bar[XB_XSUB(b.x)], 1u);
        const unsigned gen = old / nloc;
        if (old + 1u == (gen + 1u) * nloc) {
            __builtin_amdgcn_fence(__ATOMIC_RELEASE, "agent");
            asm volatile("s_waitcnt vmcnt(0)" ::: "memory");
            const unsigned og = xb_add(&bar[XB_TOP], 1u);
            const unsigned tg = og / nx;
            if (og + 1u == (tg + 1u) * nx) xb_add(&bar[XB_TOPGEN], 1u);
            else XB_SPIN(xb_ld(&bar[XB_TOPGEN]) == tg, bar);
            __builtin_amdgcn_fence(__ATOMIC_ACQUIRE, "agent");
            xb_add(&bar[XB_XGEN(b.x)], 1u);
            asm volatile("s_waitcnt vmcnt(0)" ::: "memory");
        } else {
            XB_SPIN(xb_ld(&bar[XB_XGEN(b.x)]) == gen, bar);
            __builtin_amdgcn_fence(__ATOMIC_ACQUIRE, "agent");
            asm volatile("s_waitcnt vmcnt(0)" ::: "memory");
        }
    }
    __syncthreads();
}

struct Args { const float* in[24]; float* out; unsigned char* ws; int ph_lo, ph_hi; };
enum { I_XP = 0, I_XS, I_SCONV, I_SLRU, I_SPOOL, I_META, I_N1G, I_WIN, I_CONVW, I_CONVB, I_LAM, I_WR, I_BR, I_WI, I_BI, I_POOLW, I_POOLS, I_WBRA, I_WBRB, I_WOUT, I_N2G, I_WGU, I_WDN, I_FING };

__device__ __forceinline__ void phase_init(const Args& a, int gw, int NGW, int lane) {
    float* xmeta = (float*)(a.ws + WS_XMETA); bf16_t* xb = (bf16_t*)(a.ws + WS_XBUF); float* ssq0 = (float*)(a.ws + WS_SSQ);
    for (int r = gw; r < MP; r += NGW) {
        const float* src; float* dst;
        if (r < ROWS_P) { src = a.in[I_XP] + (size_t)r * D; dst = a.out + (size_t)r * D; }
        else if (r < ROW_M0) { src = a.in[I_XS] + (size_t)(r - ROWS_P) * D; dst = a.out + (size_t)r * D; }
        else if (r < ROW_M0 + 32) { src = a.in[I_META] + (size_t)((r - ROW_M0) & 15) * D; dst = xmeta + (size_t)(r - ROW_M0) * D; }
        else { src = nullptr; dst = xmeta + (size_t)(r - ROW_M0) * D; }
        f32x4 v[4]; float s = 0.f;
#pragma unroll
        for (int j = 0; j < 4; ++j) { v[j] = src ? ((const f32x4*)src)[lane + 64 * j] : (f32x4){0.f, 0.f, 0.f, 0.f}; s += (v[j].x * v[j].x + v[j].y * v[j].y) + (v[j].z * v[j].z + v[j].w * v[j].w); }
        s = wave_sum(s);
#pragma unroll
        for (int j = 0; j < 4; ++j) { ((f32x4*)dst)[lane + 64 * j] = v[j];
            u32x2 w; w.x = cvt_pk_bf16(v[j].x, v[j].y); w.y = cvt_pk_bf16(v[j].z, v[j].w); ((u32x2*)(xb + (size_t)r * D))[lane + 64 * j] = w; }
        if (lane == 0) ssq0[r] = s;
    }
}

__device__ __forceinline__ void tr_item(const float* W, int K, int N, bf16_t* WT, int k0, int n0, int row0, const float* kscale, const float* nscale, LAS float* scr, int lane) {
#pragma unroll 8
    for (int i = 0; i < 32; ++i) { const int kk = 2 * i + (lane >> 5); float v = W[(size_t)(k0 + kk) * N + n0 + (lane & 31)]; if (kscale) v *= kscale[k0 + kk]; if (nscale) v *= nscale[n0 + (lane & 31)]; scr[kk * 33 + (lane & 31)] = v; }
    LDS_WAIT(); asm volatile("" ::: "memory");
    const int c = lane & 7;
#pragma unroll
    for (int j = 0; j < 4; ++j) { const int n = (lane >> 3) + 8 * j; const LAS float* s = scr + (8 * c) * 33 + n;
        u32x4 o; o.x = cvt_pk_bf16(s[0 * 33], s[1 * 33]); o.y = cvt_pk_bf16(s[2 * 33], s[3 * 33]); o.z = cvt_pk_bf16(s[4 * 33], s[5 * 33]); o.w = cvt_pk_bf16(s[6 * 33], s[7 * 33]);
        *(u32x4*)(WT + (size_t)(row0 + n) * K + k0 + 8 * c) = o; }
    LDS_WAIT(); asm volatile("" ::: "memory");
}
__device__ __forceinline__ void phase_weights(const Args& a, int l, LAS unsigned char* lds, int gw, int NGW, int wave, int lane) {
    LAS float* scr = (LAS float*)(lds + wave * 16384);
    constexpr int I_IN = 16 * 128, I_GU = 16 * 176, I_DN = 44 * 32, I_SQ = 16 * 32, I_PL = 4 * 8;
    constexpr int NITEMS = I_IN + I_GU + I_DN + 3 * I_SQ + 4 * I_PL;
    for (int it = gw; it < NITEMS; it += NGW) {
        int r = it;
        if (r < I_IN) { const int kb = r / 128, nb = r % 128; tr_item(a.in[I_WIN] + (size_t)l * D * NIN, D, NIN, (bf16_t*)(a.ws + W_IN), 64 * kb, 32 * nb, 32 * nb, a.in[I_N1G] + l * D, nullptr, scr, lane); continue; } r -= I_IN;
        if (r < I_GU) { const int kb = r / 176, nb = r % 176, n0 = 32 * nb; const int row0 = n0 < DFF ? (n0 >> 7) * 256 + (n0 & 127) : ((n0 - DFF) >> 7) * 256 + 128 + ((n0 - DFF) & 127);
            tr_item(a.in[I_WGU] + (size_t)l * D * NGU, D, NGU, (bf16_t*)(a.ws + W_GU), 64 * kb, n0, row0, a.in[I_N2G] + l * D, nullptr, scr, lane); continue; } r -= I_GU;
        if (r < I_DN) { const int kb = r / 32, nb = r % 32; tr_item(a.in[I_WDN] + (size_t)l * DFF * D, DFF, D, (bf16_t*)(a.ws + W_DN), 64 * kb, 32 * nb, 32 * nb, nullptr, nullptr, scr, lane); continue; } r -= I_DN;
        if (r < 3 * I_SQ) { const int w = r / I_SQ, q = r % I_SQ, kb = q / 32, nb = q % 32;
            const float* src = a.in[w == 0 ? I_WBRA : (w == 1 ? I_WBRB : I_WOUT)] + (size_t)l * D * D; bf16_t* dst = (bf16_t*)(a.ws + (w == 0 ? W_BRA : (w == 1 ? W_BRB : W_OUT)));
            tr_item(src, D, D, dst, 64 * kb, 32 * nb, 32 * nb, nullptr, nullptr, scr, lane); continue; } r -= 3 * I_SQ;
        { const int g = r / I_PL, q = r % I_PL, kb = q / 8, nb = q % 8;
          tr_item(a.in[I_POOLW] + ((size_t)l * 4 + g) * 256 * 256, 256, 256, (bf16_t*)(a.ws + W_POOL), 64 * kb, 32 * nb, g * 256 + 32 * nb, nullptr, a.in[I_POOLS] + l * D + g * 256, scr, lane); }
    }
}

__device__ __forceinline__ u32x4 ld16(const bf16_t* p) { return *(const u32x4*)p; }
__device__ __forceinline__ u32x4 ld8f_pack(const float* q) { const f32x4 a0 = *(const f32x4*)q, a1 = *(const f32x4*)(q + 4); u32x4 w; w.x = cvt_pk_bf16(a0.x, a0.y); w.y = cvt_pk_bf16(a0.z, a0.w); w.z = cvt_pk_bf16(a1.x, a1.y); w.w = cvt_pk_bf16(a1.z, a1.w); return w; }

template <int W, int R, int MODE>
__device__ __forceinline__ void pool_task(const bf16_t* PB, bf16_t* Dd, int grow0, int hrow0, int t0, const float* stq, int col0, bool zero_out) {
    u32x4 xr[W - 1 + R];
#pragma unroll
    for (int i = 0; i < W - 1; ++i) {
        if (MODE == 0) { const int rr = t0 - (W - 1) + i; xr[i] = ld16(PB + (size_t)((rr < 0 ? hrow0 : grow0 - t0) + rr) * D + col0); }
        else {
            const int rel = t0 - (W - 1) + i; const bool inr = rel >= 0;
            const u32x4 vp = ld16(PB + (size_t)(inr ? grow0 - (W - 1) + i : grow0) * D + col0);
            u32x4 vq = (u32x4){0u, 0u, 0u, 0u};
            if (MODE == 1) vq = ld8f_pack(stq + (size_t)(inr ? 0 : 15 + rel) * D);
            xr[i].x = inr ? vp.x : vq.x; xr[i].y = inr ? vp.y : vq.y; xr[i].z = inr ? vp.z : vq.z; xr[i].w = inr ? vp.w : vq.w;
        }
    }
#pragma unroll
    for (int i = 0; i < R; ++i) xr[W - 1 + i] = ld16(PB + (size_t)(grow0 + i) * D + col0);
    float s[8];
#pragma unroll
    for (int e = 0; e < 8; ++e) s[e] = 0.f;
#pragma unroll
    for (int i = 0; i < W - 1; ++i) { float v[8]; unpack8(xr[i], v);
#pragma unroll
        for (int e = 0; e < 8; ++e) s[e] += v[e]; }
#pragma unroll
    for (int i = 0; i < R; ++i) {
        float x[8]; unpack8(xr[W - 1 + i], x);
#pragma unroll
        for (int e = 0; e < 8; ++e) s[e] += x[e];
        float ic = 1.0f / (float)W;
        if (MODE == 2) { const int n = t0 + i + 1; ic = 1.0f / (float)(n < W ? n : W); }
        float d[8];
#pragma unroll
        for (int e = 0; e < 8; ++e) d[e] = zero_out ? 0.f : s[e] * ic - x[e];
        *(u32x4*)(Dd + (size_t)(grow0 + i) * D + col0) = pack8(d);
        float o[8]; unpack8(xr[i], o);
#pragma unroll
        for (int e = 0; e < 8; ++e) s[e] -= o[e];
    }
}
template <int W>
__device__ __forceinline__ void pool_wave(const Args& a, int l, int pm, int hw, int lane) {
    const int mode = pm < 64 ? 0 : (pm < 66 ? 1 : 2);
    const bf16_t* PB = (const bf16_t*)(a.ws + WS_PB); bf16_t* Dd = (bf16_t*)(a.ws + WS_XBUF);
    const float* stp = a.in[I_SPOOL] + (size_t)l * 16 * 15 * D;
    constexpr int G_ = (W == 2) ? 0 : (W == 4) ? 1 : (W == 8) ? 2 : 3;
    constexpr int R = (W == 16) ? 8 : 16;
    const int col0 = 256 * G_ + 8 * (lane & 31);
#pragma unroll 1
    for (int k = 0; k < 64 / R; ++k) {
        const int rb = (lane >> 5) + 2 * hw + 4 * k, r0 = R * rb;
        const int grow0 = (mode == 2 ? ROW_M0 : pm * 256) + r0;
        if (mode == 0) {
            const int hbase = ((pm & 31) == 0) ? ROW_M0 + (pm >> 5) * 16 + 16 : pm * 256;
            pool_task<W, R, 0>(PB, Dd, grow0, hbase, r0, nullptr, col0, false);
        } else if (mode == 1) {
            const int s = 8 * (pm - 64) + (r0 >> 5);
            pool_task<W, R, 1>(PB, Dd, grow0, 0, r0 & 31, stp + (size_t)(s * 15) * D + col0, col0, false);
        } else {
            pool_task<W, R, 2>(PB, Dd, grow0, 0, r0 & 15, nullptr, col0, r0 >= 32);
        }
    }
}
__device__ __forceinline__ void pool_unit(const Args& a, int l, int pm, int wave, int lane_in) {
    int lane = lane_in; asm volatile("" : "+v"(lane));
    const int g = wave & 3, hw = wave >> 2;
    if (g == 0) pool_wave<2>(a, l, pm, hw, lane);
    else if (g == 1) pool_wave<4>(a, l, pm, hw, lane);
    else if (g == 2) pool_wave<8>(a, l, pm, hw, lane);
    else pool_wave<16>(a, l, pm, hw, lane);
}

template <bool FINAL>
__device__ __forceinline__ void lru_unit(const Args& a, int l, int pm, int h, LAS unsigned char* lds, int tid_in, int wave, int lane_in) {
    int tid = tid_in, lane = lane_in; asm volatile("" : "+v"(tid), "+v"(lane));
    const int mode = pm < 64 ? 0 : (pm < 66 ? 1 : 2);
    bf16_t* PA = (bf16_t*)(a.ws + WS_PA); const bf16_t* haloA = (const bf16_t*)(a.ws + WS_HALOA);
    const float* stc = a.in[I_SCONV] + (size_t)l * 16 * 3 * D;
    float* sumA = (float*)(a.ws + WS_SUM); float* sumH = sumA + 68 * D;
    const int fr = lane & 15, fq = lane >> 4;
    {
        const int c8 = tid & 15, col0 = h * 128 + 8 * c8;
        float cw[4][8], cb[8];
#pragma unroll
        for (int k = 0; k < 4; ++k) { const float* p = a.in[I_CONVW] + ((size_t)l * 4 + k) * D + col0; const f32x4 a0 = *(const f32x4*)p, a1 = *(const f32x4*)(p + 4);
            cw[k][0] = a0.x; cw[k][1] = a0.y; cw[k][2] = a0.z; cw[k][3] = a0.w; cw[k][4] = a1.x; cw[k][5] = a1.y; cw[k][6] = a1.z; cw[k][7] = a1.w; }
        { const float* p = a.in[I_CONVB] + (size_t)l * D + col0; const f32x4 a0 = *(const f32x4*)p, a1 = *(const f32x4*)(p + 4);
            cb[0] = a0.x; cb[1] = a0.y; cb[2] = a0.z; cb[3] = a0.w; cb[4] = a1.x; cb[5] = a1.y; cb[6] = a1.z; cb[7] = a1.w; }
        const int rbase = (mode == 2) ? ROW_M0 : pm * 256;
#pragma unroll 2
        for (int it = 0; it < 8; it += 2) {
            u32x4 xw[2][4];
#pragma unroll
            for (int u2 = 0; u2 < 2; ++u2) {
                const int rho = (tid >> 4) + 32 * (it + u2);
#pragma unroll
                for (int k = 0; k < 4; ++k) {
                    const int back = 3 - k;
                    if (mode == 0) {
                        const int rr = rho - back;
                        const bf16_t* p = (rr >= 0) ? PA + (size_t)(rbase + rr) * D + col0 : haloA + (size_t)(pm * 3 + 3 + rr) * D + col0;
                        xw[u2][k] = ld16(p);
                    } else {
                        const int t = (mode == 1) ? (rho & 31) : (rho & 15);
                        const bool inr = back <= t;
                        const u32x4 vp = ld16(PA + (size_t)(rbase + rho - (inr ? back : 0)) * D + col0);
                        u32x4 vq = (u32x4){0u, 0u, 0u, 0u};
                        if (mode == 1) { const int sidx = (8 * (pm - 64) + (rho >> 5)) * 3 + (inr ? 0 : 3 + t - back); vq = ld8f_pack(stc + (size_t)sidx * D + col0); }
                        xw[u2][k].x = inr ? vp.x : vq.x; xw[u2][k].y = inr ? vp.y : vq.y; xw[u2][k].z = inr ? vp.z : vq.z; xw[u2][k].w = inr ? vp.w : vq.w;
                    }
                }
            }
#pragma unroll
            for (int u2 = 0; u2 < 2; ++u2) {
                const int rho = (tid >> 4) + 32 * (it + u2);
                float y[8];
#pragma unroll
                for (int e = 0; e < 8; ++e) y[e] = cb[e];
#pragma unroll
                for (int k = 0; k < 4; ++k) { float v[8]; unpack8(xw[u2][k], v);
#pragma unroll
                    for (int e = 0; e < 8; ++e) y[e] += cw[k][e] * v[e]; }
                const int swz = (rho & 3) | (((rho >> 6) & 3) << 2);
                *(LAS u32x4*)(lds + rho * 256 + 16 * (c8 ^ swz)) = pack8(y);
            }
        }
    }
    const int chl = 16 * wave + fr, ch = h * 128 + chl;
    bf16x8 Br[4], Bi[4];
    {
        const float* wr_ = a.in[I_WR] + ((size_t)(l * 8 + h) * 128) * 128 + chl; const float* wi_ = a.in[I_WI] + ((size_t)(l * 8 + h) * 128) * 128 + chl;
#pragma unroll
        for (int ks = 0; ks < 4; ++ks) { float tr[8], ti[8];
#pragma unroll
            for (int j = 0; j < 8; ++j) { const int k = 32 * ks + 8 * fq + j; tr[j] = wr_[(size_t)k * 128]; ti[j] = wi_[(size_t)k * 128]; }
            const u32x4 pr = pack8(tr), pi = pack8(ti); Br[ks] = __builtin_bit_cast(bf16x8, pr); Bi[ks] = __builtin_bit_cast(bf16x8, pi); }
    }
    const float b_r = a.in[I_BR][l * D + ch], b_i = a.in[I_BI][l * D + ch];
    float cl; { const float lam = a.in[I_LAM][l * D + ch]; cl = -8.0f * log1pf(__expf(-lam)); }
    __syncthreads();
    f32x4 ar[16], ai_[16];
#pragma unroll
    for (int mt = 0; mt < 16; ++mt) { ar[mt] = (f32x4){0.f, 0.f, 0.f, 0.f}; ai_[mt] = (f32x4){0.f, 0.f, 0.f, 0.f}; }
    {
        const int abase = ((fr >> 2) * 64 + (fr & 3)) * 256;
#pragma unroll
        for (int mt = 0; mt < 16; ++mt)
#pragma unroll
            for (int ks = 0; ks < 4; ++ks) {
                const bf16x8 af = *(const LAS bf16x8*)(lds + abase + mt * 1024 + 16 * ((4 * ks + fq) ^ fr));
                ar[mt] = __builtin_amdgcn_mfma_f32_16x16x32_bf16(af, Br[ks], ar[mt], 0, 0, 0);
                ai_[mt] = __builtin_amdgcn_mfma_f32_16x16x32_bf16(af, Bi[ks], ai_[mt], 0, 0, 0);
            }
    }
    {
        int cbase[4];
#pragma unroll
        for (int j = 0; j < 4; ++j) cbase[j] = (64 * fq) * 256 + 16 * (((chl >> 3) ^ (fq << 2)) ^ j) + 2 * (fr & 7);
#pragma unroll
        for (int mt = 0; mt < 16; ++mt)
#pragma unroll
            for (int j = 0; j < 4; ++j) {
                const float r = fast_sigmoid(ar[mt][j] + b_r), ig = fast_sigmoid(ai_[mt][j] + b_i);
                const float la = cl * r;
                const float aa = __builtin_amdgcn_exp2f(la * 1.44269504089f);
                const float x2 = la + la;
                float om = 1.0f - aa * aa;
                if (x2 > -0.03f) om = -x2 * (1.0f + x2 * (0.5f + x2 * (0.16666667f + x2 * 0.041666668f)));
                float mult = __builtin_amdgcn_sqrtf(om > 0.f ? om : 0.f);
                if (mode == 2 && fq == 0 && j == 0 && (mt == 0 || mt == 4)) mult = 1.0f;
                const float ca = __uint_as_float((unsigned)(*(const LAS unsigned short*)(lds + cbase[j] + (4 * mt + j) * 256)) << 16);
                ar[mt][j] = aa; ai_[mt][j] = mult * ig * ca;
            }
    }
    float hs = 0.f;
    if (mode == 0) {
        float A = 1.f, H = 0.f;
#pragma unroll
        for (int mt = 0; mt < 16; ++mt)
#pragma unroll
            for (int j = 0; j < 4; ++j) { H = ar[mt][j] * H + ai_[mt][j]; A *= ar[mt][j]; }
        const float A0 = __shfl(A, fr), A1 = __shfl(A, fr + 16), A2 = __shfl(A, fr + 32), A3 = __shfl(A, fr + 48);
        const float H0 = __shfl(H, fr), H1 = __shfl(H, fr + 16), H2 = __shfl(H, fr + 32), H3 = __shfl(H, fr + 48);
        if (!FINAL) {
            if (fq == 0) { sumA[(size_t)pm * D + ch] = (A0 * A1) * (A2 * A3); sumH[(size_t)pm * D + ch] = ((H0 * A1 + H1) * A2 + H2) * A3 + H3; }
        } else {
            const int b = pm >> 5, c = pm & 31;
            float ca_[8], ch_[8];
#pragma unroll
            for (int i = 0; i < 8; ++i) { const int cc = 8 * fq + i; const int idx = b * 32 + (cc < c ? cc : 0); ca_[i] = sumA[(size_t)idx * D + ch]; ch_[i] = sumH[(size_t)idx * D + ch]; }
            float hc = sumH[(size_t)(66 + b) * D + ch];
            float Ag = 1.f, Hg = 0.f;
#pragma unroll
            for (int i = 0; i < 8; ++i) { const bool ok = (8 * fq + i) < c; const float aa = ok ? ca_[i] : 1.f, hh = ok ? ch_[i] : 0.f; Hg = aa * Hg + hh; Ag *= aa; }
#pragma unroll
            for (int q = 0; q < 4; ++q) { const float aq = __shfl(Ag, fr + 16 * q), hq = __shfl(Hg, fr + 16 * q); hc = aq * hc + hq; }
            hs = hc;
            if (fq >= 1) hs = A0 * hs + H0;
            if (fq >= 2) hs = A1 * hs + H1;
            if (fq >= 3) hs = A2 * hs + H2;
        }
    }
    if (FINAL || mode == 2) {
        const float* slru = a.in[I_SLRU] + (size_t)l * 16 * D + ch;
        const int s0 = 8 * (pm - 64) + 2 * fq;
        float hcur = hs;
        if (mode == 1) hcur = slru[(size_t)s0 * D];
        float hm0 = 0.f, hm1 = 0.f;
#pragma unroll
        for (int mt = 0; mt < 16; ++mt) {
            if (mode == 1 && mt == 8) hcur = slru[(size_t)(s0 + 1) * D];
            if (mode == 2 && mt == 4) hcur = 0.f;
#pragma unroll
            for (int j = 0; j < 4; ++j) {
                hcur = ar[mt][j] * hcur + ai_[mt][j];
                if (FINAL) *(LAS unsigned short*)(lds + 65536 + (64 * fq + 4 * mt + j) * 256 + 2 * chl) = (unsigned short)(cvt_pk_bf16(hcur, 0.f) & 0xffffu);
            }
            if (mt == 3) hm0 = hcur;
            if (mt == 7) hm1 = hcur;
        }
        if (!FINAL) { if (fq == 0) { sumH[(size_t)66 * D + ch] = hm0; sumH[(size_t)67 * D + ch] = hm1; } }
        else {
            if (mode == 0 && (pm & 31) == 31 && fq == 3) a.out[O_LRU_P + (size_t)(l * 2 + (pm >> 5)) * D + ch] = hcur;
            if (mode == 1) { a.out[O_LRU_S + (size_t)(l * 16 + s0) * D + ch] = hm1; a.out[O_LRU_S + (size_t)(l * 16 + s0 + 1) * D + ch] = hcur; }
        }
    }
    __syncthreads();
    if (FINAL) {
#pragma unroll
        for (int it = 0; it < 8; ++it) { const int idx = tid + 512 * it, rho = idx >> 4, c8 = idx & 15;
            *(u32x4*)(PA + (size_t)(pm * 256 + rho) * D + h * 128 + 8 * c8) = *(const LAS u32x4*)(lds + 65536 + rho * 256 + 16 * c8); }
        __syncthreads();
    }
}

__device__ __forceinline__ void phase_final(const Args& a, int gw, int NGW, int lane) {
    const float* ssq = (const float*)(a.ws + WS_SSQ) + 4 * MP;
    for (int r = gw; r < ROW_M0; r += NGW) {
        const float rs = __builtin_amdgcn_rsqf(ssq[r] * (1.0f / D) + EPS);
        f32x4* xr = (f32x4*)(a.out + (size_t)r * D);
#pragma unroll
        for (int j = 0; j < 4; ++j) { const f32x4 gg = ((const f32x4*)a.in[I_FING])[lane + 64 * j]; f32x4 v = xr[lane + 64 * j]; v = v * rs * gg; xr[lane + 64 * j] = v; }
    }
}

#ifndef DUP_T
#define DUP_T 0
#endif
constexpr int LPH = 9 + ((DUP_T >= 1 && DUP_T <= 9) ? 1 : 0);
constexpr int N_PHASES = 2 + 2 * LPH;
#ifndef PH_MASK
#define PH_MASK 0xFFFF
#endif
#define PT(t) ((PH_MASK >> (t)) & 1)
__global__ void __launch_bounds__(NWAVES * 64, 2) fwd_kernel(Args args) {
    extern __shared__ __attribute__((aligned(16))) unsigned char lds_raw[];
    LAS unsigned char* lds = (LAS unsigned char*)lds_raw;
    {
        const int tid0 = threadIdx.x;
        for (int u = tid0; u < (LDS_BYTES - LDSCTL_OFF) / 4; u += NWAVES * 64) ((LAS unsigned*)(lds + LDSCTL_OFF))[u] = 0u;
        __syncthreads();
    }
    XcdBarrier bar; bar.bar = (unsigned*)(args.ws + WS_CTL) + CW_BAR; bar.x = 0; bar.st = (volatile LAS unsigned*)(lds + MISC_OFF) + 8;
    if (!MK_PER_PHASE) bar = xcd_barrier_post(bar.bar, bar.st);
    const int lo = args.ph_lo, hi = args.ph_hi;
#pragma unroll 1
    for (int ph = lo; ph < hi; ++ph) {
        int tid = threadIdx.x; asm volatile("" : "+v"(tid));
        const int lane = tid & 63, wave = __builtin_amdgcn_readfirstlane(tid >> 6);
        const int G = gridDim.x, bx = blockIdx.x;
        const int vcu = (G % 8 == 0) ? (bx % 8) * (G / 8) + bx / 8 : bx;
        const int gw = vcu * NWAVES + wave, NGW = G * NWAVES;
        float* ssq = (float*)(args.ws + WS_SSQ);
        bf16_t* XBUF = (bf16_t*)(args.ws + WS_XBUF);
        bf16_t* PA = (bf16_t*)(args.ws + WS_PA);
        const int l = ph >= 1 + LPH ? 1 : 0;
        int pt;
        if (ph == 0) pt = 0; else if (ph == N_PHASES - 1) pt = 10; else { const int i = ph - 1 - LPH * l; pt = (DUP_T >= 1 && DUP_T <= 9 && i > DUP_T - 1) ? i : i + 1; }
        bool seam = true;
        switch (pt) {
        case 0: if (PT(0)) { phase_init(args, gw, NGW, lane); seam = false; } break;
        case 1: if (PT(1)) { phase_weights(args, l, lds, gw, NGW, wave, lane); } break;
        case 2: if (PT(2)) {
            pg8::Gemm g{XBUF, (const bf16_t*)(args.ws + W_IN), MP, NIN, D, D, 0}; pg8::StaticOrder S; S.init(MP, NIN, G, bx);
            EpiIn E{PA, (bf16_t*)(args.ws + WS_HALOA), ssq + (size_t)(2 * l) * MP, args.out, l};
            pg8::gemm_phase(lds, g, S, E); } break;
        case 3: if (PT(3)) {
            constexpr int NL = 65 * 8;
            for (int u = vcu; u < NL + NTILE; u += G) {
                if (u < NL) { const int t = u >> 3; lru_unit<false>(args, l, t < 64 ? t : 66, u & 7, lds, tid, wave, lane); }
                else pool_unit(args, l, u - NL, wave, lane);
            } } break;
        case 4: if (PT(4)) {
            for (int u = vcu; u < NTILE * 8; u += G) lru_unit<true>(args, l, u >> 3, u & 7, lds, tid, wave, lane);
            pg8::Gemm g{XBUF, (const bf16_t*)(args.ws + W_POOL), MP, D, 256, D, 256}; pg8::StaticOrder S; S.init(MP, D, G, bx);
            EpiStore E{(bf16_t*)(args.ws + WS_YB), D};
            pg8::gemm_phase(lds, g, S, E); } break;
        case 5: if (PT(5)) {
            pg8::Gemm g{PA, (const bf16_t*)(args.ws + W_BRA), MP, D, D, D, 0}; pg8::StaticOrder S; S.init(MP, D, G, bx);
            EpiGate<false> E{(const bf16_t*)(args.ws + WS_PGA), nullptr, XBUF};
            pg8::gemm_phase(lds, g, S, E); } break;
        case 6: if (PT(6)) {
            pg8::Gemm g{(const bf16_t*)(args.ws + WS_YB), (const bf16_t*)(args.ws + W_BRB), MP, D, D, D, 0}; pg8::StaticOrder S; S.init(MP, D, G, bx);
            EpiGate<true> E{(const bf16_t*)(args.ws + WS_PGB), XBUF, PA};
            pg8::gemm_phase(lds, g, S, E); } break;
        case 7: if (PT(7)) {
            pg8::Gemm g{PA, (const bf16_t*)(args.ws + W_OUT), MP, D, D, D, 0}; pg8::StaticOrder S; S.init(MP, D, G, bx);
            EpiRes E{args.out, (float*)(args.ws + WS_XMETA), XBUF, ssq + (size_t)(2 * l + 1) * MP};
            pg8::gemm_phase(lds, g, S, E); } break;
        case 8: if (PT(8)) {
            pg8::Gemm g{XBUF, (const bf16_t*)(args.ws + W_GU), MP, NGU, D, D, 0}; pg8::StaticOrder S; S.init(MP, NGU, G, bx);
            EpiGU E{PA, ssq + (size_t)(2 * l + 1) * MP};
            pg8::gemm_phase(lds, g, S, E); } break;
        case 9: if (PT(9)) {
            pg8::Gemm g{PA, (const bf16_t*)(args.ws + W_DN), MP, D, DFF, DFF, 0}; pg8::StaticOrder S; S.init(MP, D, G, bx);
            EpiRes E{args.out, (float*)(args.ws + WS_XMETA), XBUF, ssq + (size_t)(2 * l + 2) * MP};
            pg8::gemm_phase(lds, g, S, E); } break;
        default: if (PT(10)) { phase_final(args, gw, NGW, lane); } break;
        }
        __syncthreads();
        if (seam && ph + 1 < hi) xcd_barrier(bar);
    }
}

extern "C" void kernel_launch(void* const* d_in, const int* in_sizes, int n_in, void* d_out, int out_size, void* d_ws, size_t ws_size, hipStream_t stream) {
    static int grid = 0;
    if (grid == 0) {
        if (n_in != 24 || (size_t)out_size != O_END || ws_size < WS_END) { fprintf(stderr, "kernel_launch: unexpected shapes (n_in %d out %d ws %zu)\n", n_in, out_size, ws_size); grid = -1; return; }
        int dev = 0, cus = 0, per_cu = 0;
        if (hipGetDevice(&dev) != hipSuccess || hipDeviceGetAttribute(&cus, hipDeviceAttributeMultiprocessorCount, dev) != hipSuccess) { grid = -1; return; }
        if (hipFuncSetAttribute((const void*)fwd_kernel, hipFuncAttributeMaxDynamicSharedMemorySize, LDS_BYTES) != hipSuccess) { fprintf(stderr, "kernel_launch: hipFuncSetAttribute failed\n"); grid = -1; return; }
        if (hipOccupancyMaxActiveBlocksPerMultiprocessor(&per_cu, (const void*)fwd_kernel, NWAVES * 64, LDS_BYTES) != hipSuccess || per_cu < 1) { fprintf(stderr, "kernel_launch: occupancy query says %d\n", per_cu); (void)hipGetLastError(); grid = -1; return; }
        grid = cus;
    }
    if (grid < 0) return;
    (void)hipMemsetAsync((char*)d_ws + WS_CTL, 0, CTL_ZERO_BYTES, stream);
    Args a{};
    for (int i = 0; i < 24; ++i) a.in[i] = (const float*)d_in[i];
    a.out = (float*)d_out; a.ws = (unsigned char*)d_ws;
#if MK_PER_PHASE
    for (int p = 0; p < N_PHASES; ++p) { a.ph_lo = p; a.ph_hi = p + 1; hipLaunchKernelGGL(fwd_kernel, dim3(grid), dim3(NWAVES * 64), LDS_BYTES, stream, a); }
#else
    a.ph_lo = 0; a.ph_hi = N_PHASES;
    void* kargs[] = {&a};
    hipError_t e = hipLaunchCooperativeKernel((const void*)fwd_kernel, dim3(grid), dim3(NWAVES * 64), kargs, LDS_BYTES, stream);
    if (e != hipSuccess) fprintf(stderr, "kernel_launch: cooperative launch failed: %s (grid %d)\n", hipGetErrorString(e), grid);
#endif
}
```
